# Optimizing an MI355X kernel written in HIP

```python
import jax, jax.numpy as jnp
from jax import lax
import numpy as np

D_MODEL = 2048
BATCH = 4
SEQ = 4096
DEPTH = 1
DEC_BATCH = 1
DEC_SEQ = 16384
PAST_LEN = 128

GRID_W = 64
D_CONV = D_MODEL // 2
CONV_K = 3
N_HEADS = 16
HEAD_DIM = 64
D_ATTN = N_HEADS * HEAD_DIM
WIN_R = 8
WIN_C = 16
RMS_EPS = 1e-6
IN_SIZES = (D_CONV, D_CONV, D_CONV, D_CONV,
            D_ATTN, D_ATTN, D_ATTN, D_ATTN,
            D_MODEL, D_MODEL)
D_IN = sum(IN_SIZES)
IN_SPLITS = tuple(int(s) for s in np.cumsum(IN_SIZES)[:-1])

kernel_name = "hybrid_shortconv_neighbourhood_attn_encoder"


def _rms(x, g):
    xf = x.astype(jnp.float32)
    xf = xf * lax.rsqrt(jnp.mean(xf * xf, axis=-1, keepdims=True) + RMS_EPS)
    return (xf * g.astype(jnp.float32)).astype(x.dtype)


def _neigh_attn(q, k, v, rpb):
    b, L, h, dh = q.shape
    rows = L // GRID_W
    wr = min(WIN_R, rows)
    q = q.reshape(b, rows, GRID_W, h, dh)
    k = k.reshape(b, rows, GRID_W, h, dh)
    v = v.reshape(b, rows, GRID_W, h, dh)
    cols = jnp.arange(GRID_W)
    col_start = jnp.clip(cols - WIN_C // 2, 0, GRID_W - WIN_C)
    col_idx = col_start[:, None] + jnp.arange(WIN_C)[None, :]
    dc_idx = col_idx - cols[:, None] + (WIN_C - 1)
    scale = HEAD_DIM ** -0.5

    def row_step(r):
        rs = jnp.clip(r - wr // 2, 0, rows - wr)
        k_rows = lax.dynamic_slice_in_dim(k, rs, wr, axis=1)
        v_rows = lax.dynamic_slice_in_dim(v, rs, wr, axis=1)
        k_win = k_rows[:, :, col_idx]
        v_win = v_rows[:, :, col_idx]
        q_r = lax.dynamic_index_in_dim(q, r, axis=1, keepdims=False)
        s = jnp.einsum('bchd,bicjhd->bhcij', q_r, k_win).astype(jnp.float32) * scale
        dr_idx = rs + jnp.arange(wr) - r + (WIN_R - 1)
        bias = rpb[:, dr_idx][:, :, dc_idx]
        s = s + jnp.transpose(bias, (0, 2, 1, 3)).astype(jnp.float32)[None]
        p = jax.nn.softmax(s.reshape(b, h, GRID_W, wr * WIN_C), axis=-1)
        p = p.reshape(b, h, GRID_W, wr, WIN_C).astype(v.dtype)
        return jnp.einsum('bhcij,bicjhd->bchd', p, v_win)

    out = lax.map(row_step, jnp.arange(rows))
    return jnp.transpose(out, (1, 0, 2, 3, 4)).reshape(b, L, h * dh)


def _layer(x, c, norm_g, w_ada, b_ada, w_in, conv_w, conv_b, q_norm_g, k_norm_g,
           rpb, w_pa, w_pb, w_o):
    bsz, L, _ = x.shape
    mod = jax.nn.silu(c) @ w_ada + b_ada
    shift, scl, gate = jnp.split(mod, 3, axis=-1)
    h = _rms(x, norm_g) * (1 + scl[:, None, :]) + shift[:, None, :]
    z = h @ w_in
    a_b, a_c, a_x, a_z, q, k, v, b_z, g_a, g_b = jnp.split(z, IN_SPLITS, axis=-1)
    u = a_c * a_x
    pad = CONV_K // 2
    up = jnp.pad(u, ((0, 0), (pad, CONV_K - 1 - pad), (0, 0)))
    conv = sum(up[:, i:i + L] * conv_w[i] for i in range(CONV_K)) + conv_b
    y_a = a_b * conv * jax.nn.silu(a_z)
    q = _rms(q.reshape(bsz, L, N_HEADS, HEAD_DIM), q_norm_g)
    k = _rms(k.reshape(bsz, L, N_HEADS, HEAD_DIM), k_norm_g)
    v = v.reshape(bsz, L, N_HEADS, HEAD_DIM)
    y_b = _neigh_attn(q, k, v, rpb) * jax.nn.silu(b_z)
    m = jax.nn.sigmoid(g_a) * (y_a @ w_pa) + jax.nn.sigmoid(g_b) * (y_b @ w_pb)
    return x + gate[:, None, :] * (m @ w_o)


def setup_inputs(seed: int = 0) -> dict:
    key = jax.random.key(seed)
    ks = jax.random.split(key, 16)
    f32 = jnp.float32
    n = lambda k, shape, s: (jax.random.normal(k, shape, f32) * s).astype(f32)
    return {
        "x_prompt": n(ks[0], (BATCH, SEQ, D_MODEL), 1.0),
        "x_sample": n(ks[1], (DEC_BATCH, DEC_SEQ, D_MODEL), 1.0),
        "c_prompt": n(ks[2], (BATCH, D_MODEL), 1.0),
        "c_sample": n(ks[3], (DEC_BATCH, D_MODEL), 1.0),
        "norm_g": 1.0 + n(ks[4], (DEPTH, D_MODEL), 0.01),
        "w_ada": n(ks[5], (DEPTH, D_MODEL, 3 * D_MODEL), 0.5 * D_MODEL ** -0.5),
        "b_ada": n(ks[6], (DEPTH, 3 * D_MODEL), 0.01),
        "w_in": n(ks[7], (DEPTH, D_MODEL, D_IN), D_MODEL ** -0.5),
        "conv_w": n(ks[8], (DEPTH, CONV_K, D_CONV), CONV_K ** -0.5),
        "conv_b": n(ks[9], (DEPTH, D_CONV), 0.01),
        "q_norm_g": 1.0 + n(ks[10], (DEPTH, HEAD_DIM), 0.01),
        "k_norm_g": 1.0 + n(ks[11], (DEPTH, HEAD_DIM), 0.01),
        "rpb": n(ks[12], (DEPTH, N_HEADS, 2 * WIN_R - 1, 2 * WIN_C - 1), 0.1),
        "w_pa": n(ks[13], (DEPTH, D_CONV, D_MODEL), D_CONV ** -0.5),
        "w_pb": n(ks[14], (DEPTH, D_ATTN, D_MODEL), D_ATTN ** -0.5),
        "w_o": n(ks[15], (DEPTH, D_MODEL, D_MODEL), D_MODEL ** -0.5),
    }


def reference(x_prompt, x_sample, c_prompt, c_sample, norm_g, w_ada, b_ada, w_in,
              conv_w, conv_b, q_norm_g, k_norm_g, rpb, w_pa, w_pb, w_o):
    y_prompt = x_prompt
    y_sample = x_sample
    for l in range(DEPTH):
        params = (norm_g[l], w_ada[l], b_ada[l], w_in[l], conv_w[l], conv_b[l],
                  q_norm_g[l], k_norm_g[l], rpb[l], w_pa[l], w_pb[l], w_o[l])
        y_prompt = _layer(y_prompt, c_prompt, *params)
        y_sample = _layer(y_sample, c_sample, *params)
    return (y_prompt, y_sample)
```

```cpp
#include <hip/hip_runtime.h>
#include <hip/hip_cooperative_groups.h>
#include <cstdio>
#include <cstdint>
namespace cg = cooperative_groups;
namespace pg8 {
#define PG8_LAS __attribute__((address_space(3)))
typedef unsigned short bf16_t;
typedef short bf16x8 __attribute__((ext_vector_type(8)));
typedef float f32x4 __attribute__((ext_vector_type(4)));
typedef unsigned u32x4 __attribute__((ext_vector_type(4)));
constexpr int BM = 256, BK = 64, HALF = 128, HTB = HALF * BK * 2  , STAGE_BYTES = 8 * HTB, NXCD = 8, WGM = 4;
__host__ __device__ __forceinline__ int lds_byte(int r, int c) { const int st = (r >> 4) * 2 + (c >> 5), rr = r & 15, cc = c & 31, ob = rr * 64 + cc * 2; return st * 1024 + (ob ^ (((ob >> 9) & 1) << 5)); }
__host__ __device__ __forceinline__ void stage_rc(int b, int& R, int& C) { const int st = b / 1024, sb = b % 1024, swz = sb ^ (((sb >> 9) & 1) << 5); R = (st >> 1) * 16 + swz / 64; C = (st & 1) * 32 + (swz % 64) / 2; }
__host__ __device__ __forceinline__ int perm32(int rho) { const int n = rho >> 4, i = rho & 15; return 8 * (i >> 2) + 4 * n + (i & 3); }
struct Unit { int pm, pn, sel; };
struct Gemm { const bf16_t* A; const bf16_t* Bt; int M, N, K; const bf16_t* A2; const bf16_t* Bt2; };
struct StaticOrder {
    int nM, nN, nwg, G, c;
    __host__ __device__ void init(int M, int N, int G_, int c_) { nM = M / BM; nN = N / BM; nwg = nM * nN; G = G_; c = c_; }
    __host__ __device__ bool next(int i, Unit& u) const {
        const long L = (long)i * G + c; if (L >= nwg) return false;
        int wgid = (int)L; { const int q = nwg / NXCD, r = nwg % NXCD, xcd = wgid % NXCD, off = wgid / NXCD; wgid = (xcd < r ? xcd * (q + 1) : r * (q + 1) + (xcd - r) * q) + off; }
        const int nig = WGM * nN, gid = wgid / nig, fm = gid * WGM, gsz = (nM - fm) < WGM ? (nM - fm) : WGM;
        u.pm = fm + ((wgid % nig) % gsz); u.pn = (wgid % nig) / gsz; u.sel = 0; return true;
    }
    __device__ __forceinline__ void a_ready(const Unit&) const {}
    __device__ __forceinline__ void done(const Unit&) const {}
};

typedef _Float16 h16x2n __attribute__((ext_vector_type(2)));
typedef _Float16 h16x8 __attribute__((ext_vector_type(8)));
typedef float f32x2n __attribute__((ext_vector_type(2)));
__device__ __forceinline__ unsigned cvt_pk_bf16(float lo, float hi) { const f32x2n v = {lo, hi}; return __builtin_bit_cast(unsigned, __builtin_convertvector(v, h16x2n)); }
typedef __bf16 rbf16x2n __attribute__((ext_vector_type(2)));
__device__ __forceinline__ unsigned cvt_pk_rbf16(float lo, float hi) { const f32x2n v = {lo, hi}; return __builtin_bit_cast(unsigned, __builtin_convertvector(v, rbf16x2n)); }
__device__ __forceinline__ f32x4 mfma_bf(const bf16x8 a, const bf16x8 b, const f32x4 c) { return __builtin_amdgcn_mfma_f32_16x16x32_bf16(a, b, c, 0, 0, 0); }
__device__ __forceinline__ f32x4 mfma16(const bf16x8 a, const bf16x8 b, const f32x4 c) { return __builtin_amdgcn_mfma_f32_16x16x32_f16(__builtin_bit_cast(h16x8, a), __builtin_bit_cast(h16x8, b), c, 0, 0, 0); }
typedef unsigned u32x2 __attribute__((ext_vector_type(2)));
__device__ __forceinline__ float fsigmoid(float x) { return __builtin_amdgcn_rcpf(1.0f + __builtin_amdgcn_exp2f(-1.4426950408889634f * x)); }
__device__ __forceinline__ float bf_lo(unsigned w) { return (float)__builtin_bit_cast(h16x2n, w)[0]; }
__device__ __forceinline__ float bf_hi(unsigned w) { return (float)__builtin_bit_cast(h16x2n, w)[1]; }
__device__ __forceinline__ u32x4 pack8(const f32x4 a, const f32x4 b) { u32x4 w; w.x = cvt_pk_bf16(a[0], a[1]); w.y = cvt_pk_bf16(a[2], a[3]); w.z = cvt_pk_bf16(b[0], b[1]); w.w = cvt_pk_bf16(b[2], b[3]); return w; }
__device__ __forceinline__ void unpack8(const u32x4 w, f32x4& a, f32x4& b) { a = (f32x4){bf_lo(w.x), bf_hi(w.x), bf_lo(w.y), bf_hi(w.y)}; b = (f32x4){bf_lo(w.z), bf_hi(w.z), bf_lo(w.w), bf_hi(w.w)}; }

struct EpiIn {
    static constexpr bool PERM = false, AFTER_DRAIN = false;
    bf16_t *U, *GA, *Q, *Kb, *V, *SBZ; const float *qg, *kg; bf16_t *SGA, *SGB;
    __device__ __forceinline__ void operator()(const f32x4 (&acc)[2][2][4][2], const Unit& u, int wr, int wc, int fr, int fq) const {
        const int row0 = u.pm * BM + wr * 64 + fr;
        if (u.pn < 16) {
            const int ch0 = u.pn * 64 + wc * 16 + fq * 4;
#pragma unroll
            for (int ai = 0; ai < 2; ++ai)
#pragma unroll
                for (int m = 0; m < 4; ++m) { const size_t off = (size_t)(row0 + ai * HALF + m * 16) * 1024 + ch0;
                    const f32x4 ab = acc[ai][0][m][0], ac = acc[ai][0][m][1], ax = acc[ai][1][m][0], az = acc[ai][1][m][1];
                    f32x4 uu = ac * ax, ga;
#pragma unroll
                    for (int j = 0; j < 4; ++j) ga[j] = ab[j] * az[j] * fsigmoid(az[j]);
                    u32x2 wu, wg; wu.x = cvt_pk_bf16(uu[0], uu[1]); wu.y = cvt_pk_bf16(uu[2], uu[3]); wg.x = cvt_pk_bf16(ga[0], ga[1]); wg.y = cvt_pk_bf16(ga[2], ga[3]);
                    *(u32x2*)(U + off) = wu; *(u32x2*)(GA + off) = wg; }
        } else if (u.pn < 24) {
            const bool isq = u.pn < 20; bf16_t* dst = isq ? Q : Kb; const float* g = (isq ? qg : kg) + 8 * fq; const float mul = isq ? 0.125f * 1.4426950408889634f : 1.0f;
            const int col0 = ((u.pn - 16) & 3) * 256 + wc * 64 + fq * 8;
            f32x4 gv[2][2];
#pragma unroll
            for (int bj = 0; bj < 2; ++bj)
#pragma unroll
                for (int n = 0; n < 2; ++n) gv[bj][n] = *(const f32x4*)(g + 32 * bj + 4 * n) * mul;
#pragma unroll
            for (int ai = 0; ai < 2; ++ai)
#pragma unroll
                for (int m = 0; m < 4; ++m) { float ss = 0.f;
#pragma unroll
                    for (int bj = 0; bj < 2; ++bj)
#pragma unroll
                        for (int n = 0; n < 2; ++n) { const f32x4 x = acc[ai][bj][m][n]; ss += (x[0] * x[0] + x[1] * x[1]) + (x[2] * x[2] + x[3] * x[3]); }
                    ss += __shfl_xor(ss, 16); ss += __shfl_xor(ss, 32);
                    const float rinv = __builtin_amdgcn_rsqf(ss * (1.0f / 64.0f) + 1e-6f);
                    bf16_t* rowp = dst + (size_t)(row0 + ai * HALF + m * 16) * 1024 + col0;
#pragma unroll
                    for (int bj = 0; bj < 2; ++bj) *(u32x4*)(rowp + 32 * bj) = pack8(acc[ai][bj][m][0] * rinv * gv[bj][0], acc[ai][bj][m][1] * rinv * gv[bj][1]); }
        } else if (u.pn < 32) {
            const bool isv = u.pn < 28; bf16_t* dst = isv ? V : SBZ; const int col0 = ((u.pn - 24) & 3) * 256 + wc * 64 + fq * 8;
#pragma unroll
            for (int ai = 0; ai < 2; ++ai)
#pragma unroll
                for (int m = 0; m < 4; ++m) { bf16_t* rowp = dst + (size_t)(row0 + ai * HALF + m * 16) * 1024 + col0;
#pragma unroll
                    for (int bj = 0; bj < 2; ++bj) { f32x4 v0 = acc[ai][bj][m][0], v1 = acc[ai][bj][m][1];
                        if (!isv) {
#pragma unroll
                            for (int j = 0; j < 4; ++j) { v0[j] = v0[j] * fsigmoid(v0[j]); v1[j] = v1[j] * fsigmoid(v1[j]); } }
                        *(u32x4*)(rowp + 32 * bj) = pack8(v0, v1); } }
        } else {
            unsigned char* dst = (unsigned char*)(u.pn < 40 ? SGA : SGB) + (u.pn & 7) * 256 + wc * 64 + fq * 16;
#pragma unroll
            for (int ai = 0; ai < 2; ++ai)
#pragma unroll
                for (int m = 0; m < 4; ++m) { u32x4 w;
#pragma unroll
                    for (int bj = 0; bj < 2; ++bj)
#pragma unroll
                        for (int n = 0; n < 2; ++n) { const f32x4 v = acc[ai][bj][m][n]; unsigned q = 0;
#pragma unroll
                            for (int j = 0; j < 4; ++j) q |= (unsigned)(fsigmoid(v[j]) * 255.0f + 0.5f) << (8 * j);
                            w[2 * bj + n] = q; }
                    *(u32x4*)(dst + (size_t)(row0 + ai * HALF + m * 16) * 2048) = w; }
        }
    }
};
struct EpiGate {
    static constexpr bool PERM = false, AFTER_DRAIN = false;
    bf16_t *SGA, *SGB;
    __device__ __forceinline__ void operator()(const f32x4 (&acc)[2][2][4][2], const Unit& u, int wr, int wc, int fr, int fq) const {
        const int row0 = u.pm * BM + wr * 64 + fr; bf16_t* dst = (u.pn < 8 ? SGA : SGB) + (u.pn & 7) * 256 + wc * 64 + fq * 8;
#pragma unroll
        for (int ai = 0; ai < 2; ++ai)
#pragma unroll
            for (int m = 0; m < 4; ++m) { bf16_t* rowp = dst + (size_t)(row0 + ai * HALF + m * 16) * 2048;
#pragma unroll
                for (int bj = 0; bj < 2; ++bj) { f32x4 v0 = acc[ai][bj][m][0], v1 = acc[ai][bj][m][1];
#pragma unroll
                    for (int j = 0; j < 4; ++j) { v0[j] = fsigmoid(v0[j]); v1[j] = fsigmoid(v1[j]); }
                    *(u32x4*)(rowp + 32 * bj) = pack8(v0, v1); } }
    }
};
template <int PASS> struct EpiMerge {
    static constexpr bool PERM = false, AFTER_DRAIN = false;
    bf16_t* Mb; const unsigned char* G8;
    __device__ __forceinline__ void operator()(const f32x4 (&acc)[2][2][4][2], const Unit& u, int wr, int wc, int fr, int fq) const {
        const int row0 = u.pm * BM + wr * 64 + fr;
        bf16_t* mb = Mb + (size_t)row0 * 2048 + (size_t)u.pn * 256 + wc * 64 + fq * 8;
        const unsigned char* __restrict__ g8 = G8 + (size_t)row0 * 2048 + (size_t)u.pn * 256 + wc * 64 + fq * 16;
        u32x4 cg, ng, cm[2], nm[2];
        cg = *(const u32x4*)g8;
        if (PASS == 1) {
#pragma unroll
            for (int bj = 0; bj < 2; ++bj) cm[bj] = *(const u32x4*)(mb + 32 * bj); }
#pragma unroll
        for (int g = 0; g < 8; ++g) { const int ai = g >> 2, m = g & 3; const size_t off = (size_t)(ai * HALF + m * 16) * 2048;
            if (g < 7) { const int ai2 = (g + 1) >> 2, m2 = (g + 1) & 3; const size_t off2 = (size_t)(ai2 * HALF + m2 * 16) * 2048;
                ng = *(const u32x4*)(g8 + off2);
                if (PASS == 1) {
#pragma unroll
                    for (int bj = 0; bj < 2; ++bj) nm[bj] = *(const u32x4*)(mb + off2 + 32 * bj); } }
#pragma unroll
            for (int bj = 0; bj < 2; ++bj) { f32x4 gq[2];
#pragma unroll
                for (int n = 0; n < 2; ++n) { const unsigned q = cg[2 * bj + n];
#pragma unroll
                    for (int j = 0; j < 4; ++j) gq[n][j] = (float)((q >> (8 * j)) & 255u) * (PASS == 0 ? 4.0f / 255.0f : 1.0f / 255.0f); }
                f32x4 a, b;
                if (PASS == 0) { a = gq[0] * acc[ai][bj][m][0]; b = gq[1] * acc[ai][bj][m][1]; }
                else { unpack8(cm[bj], a, b); a = a + gq[0] * acc[ai][bj][m][0]; b = b + gq[1] * acc[ai][bj][m][1]; }
                *(u32x4*)(mb + off + 32 * bj) = pack8(a, b); }
            cg = ng;
            if (PASS == 1) {
#pragma unroll
                for (int bj = 0; bj < 2; ++bj) cm[bj] = nm[bj]; } }
    }
};
struct PairOrder : StaticOrder { __device__ __forceinline__ bool next(int i, Unit& u) const { const bool r = StaticOrder::next(i >> 1, u); u.sel = i & 1; return r; } };
struct EpiMerge2 {
    static constexpr bool PERM = false, AFTER_DRAIN = false;
    bf16_t* Mb; const unsigned char* G8A; const unsigned char* G8B;
    __device__ __forceinline__ void operator()(const f32x4 (&acc)[2][2][4][2], const Unit& u, int wr, int wc, int fr, int fq) const {
        if (u.sel == 0) { const EpiMerge<0> e{Mb, G8A}; e(acc, u, wr, wc, fr, fq); } else { const EpiMerge<1> e{Mb, G8B}; e(acc, u, wr, wc, fr, fq); }
    }
};
struct EpiOut {
    static constexpr bool PERM = false, AFTER_DRAIN = false;
    const float *xp, *xs, *gate; float* out;
    __device__ __forceinline__ void operator()(const f32x4 (&acc)[2][2][4][2], const Unit& u, int wr, int wc, int fr, int fq) const {
        const int row0 = u.pm * BM + wr * 64 + fr, col0 = u.pn * 256 + wc * 64 + fq * 4; const int b = u.pm < 64 ? (u.pm >> 4) : 4;
        const float* __restrict__ xr = (u.pm < 64 ? xp : xs - (size_t)16384 * 2048) + (size_t)row0 * 2048 + col0;
        float* __restrict__ op = out + (size_t)row0 * 2048 + col0;
        f32x4 gv[2][2];
#pragma unroll
        for (int bj = 0; bj < 2; ++bj)
#pragma unroll
            for (int n = 0; n < 2; ++n) gv[bj][n] = *(const f32x4*)(gate + b * 2048 + col0 + 32 * bj + 16 * n);
        f32x4 cx[4], nx[4];
#pragma unroll
        for (int q = 0; q < 4; ++q) cx[q] = *(const f32x4*)(xr + 16 * q);
#pragma unroll
        for (int g = 0; g < 8; ++g) { const int ai = g >> 2, m = g & 3; const size_t off = (size_t)(ai * HALF + m * 16) * 2048;
            if (g < 7) { const int ai2 = (g + 1) >> 2, m2 = (g + 1) & 3; const size_t off2 = (size_t)(ai2 * HALF + m2 * 16) * 2048;
#pragma unroll
                for (int q = 0; q < 4; ++q) nx[q] = *(const f32x4*)(xr + off2 + 16 * q); }
#pragma unroll
            for (int q = 0; q < 4; ++q) { const int bj = q >> 1, n = q & 1; *(f32x4*)(op + off + 16 * q) = cx[q] + gv[bj][n] * acc[ai][bj][m][n]; }
#pragma unroll
            for (int q = 0; q < 4; ++q) cx[q] = nx[q]; }
    }
};
template <class Epi, class Sched, bool ALIGN_EPI = false, bool SP2 = false, bool BFOPS = false>
__device__ __forceinline__ void gemm_phase(PG8_LAS unsigned char* lds, const Gemm g, const Sched& S, const Epi& E) {
    const int tid = threadIdx.x, wid = __builtin_amdgcn_readfirstlane(tid >> 6), lane = tid & 63, wr = wid >> 2, wc = wid & 3, fr = lane & 15, fq = lane >> 4;
    const int K = g.K, nt = K / BK;
    unsigned voffA[2], voffB[2];
#pragma unroll
    for (int i = 0; i < 2; ++i) { int R, C; stage_rc(tid * 16 + i * 8192, R, C); const int Rb = Epi::PERM ? ((R & ~31) + perm32(R & 31)) : R;
        voffA[i] = (unsigned)(R * K + C) * 2u; voffB[i] = (unsigned)(Rb * K + C) * 2u; }
    const size_t kstep = (size_t)(BK * 2);
    const size_t hstep = (size_t)HALF * K * 2;
    const size_t tstep = 2 * hstep;
    const unsigned ldsw = (unsigned)wid * 1024u;
    const int aoff = lds_byte(wr * 64 + fr, fq * 8), boff = lds_byte(wc * 32 + fr, fq * 8);
#define PG8_SA(b, h) (((b) * 2 + (h)) * HTB)
#define PG8_SB(b, h) ((4 + (b) * 2 + (h)) * HTB)
#define PG8_STAGE(bufoff, gbase, voff) do { _Pragma("unroll") for (int _i = 0; _i < 2; ++_i) \
        __builtin_amdgcn_global_load_lds((const unsigned*)((const char*)(gbase) + (voff)[_i]), (PG8_LAS unsigned*)(lds + (bufoff) + ldsw + _i * 8192), 16, 0, 0); } while (0)
#define PG8_LDA(dst, b, h) do { _Pragma("unroll") for (int m = 0; m < 4; ++m) _Pragma("unroll") for (int k = 0; k < 2; ++k) dst[m][k] = *(const PG8_LAS bf16x8*)(lds + PG8_SA(b, h) + aoff + m * 2048 + k * 1024); } while (0)
#define PG8_LDB(dst, b, h) do { _Pragma("unroll") for (int n = 0; n < 2; ++n) _Pragma("unroll") for (int k = 0; k < 2; ++k) dst[n][k] = *(const PG8_LAS bf16x8*)(lds + PG8_SB(b, h) + boff + n * 2048 + k * 1024); } while (0)
#define PG8_MMA(ai, bj, At, Bt) do { __builtin_amdgcn_s_setprio(1); _Pragma("unroll") for (int m = 0; m < 4; ++m) _Pragma("unroll") for (int n = 0; n < 2; ++n) _Pragma("unroll") for (int k = 0; k < 2; ++k) \
        acc[ai][bj][m][n] = BFOPS ? mfma_bf(Bt[n][k], At[m][k], acc[ai][bj][m][n]) : mfma16(Bt[n][k], At[m][k], acc[ai][bj][m][n]); __builtin_amdgcn_s_setprio(0); } while (0)
#define PG8_WAIT_V(n) asm volatile("s_waitcnt vmcnt(" #n ")" ::: "memory")
#define PG8_WAIT_L(n) asm volatile("s_waitcnt lgkmcnt(" #n ")" ::: "memory")
#define PG8_BAR __builtin_amdgcn_s_barrier()
#define PG8_SCHED __builtin_amdgcn_sched_barrier(0)
    Unit cur, nxt; int ui = 0;
    if (!S.next(0, cur)) return;
    f32x4 acc[2][2][4][2];
#pragma unroll
    for (int a = 0; a < 2; ++a)
#pragma unroll
        for (int b = 0; b < 2; ++b)
#pragma unroll
            for (int m = 0; m < 4; ++m)
#pragma unroll
                for (int n = 0; n < 2; ++n) acc[a][b][m][n] = (f32x4){0.f, 0.f, 0.f, 0.f};
    bf16x8 At[4][2], B0[2][2], B1[2][2];
    const char* cA = (const char*)(cur.sel ? g.A2 : g.A) + (size_t)cur.pm * tstep; const char* cB = (const char*)(cur.sel ? g.Bt2 : g.Bt) + (size_t)cur.pn * tstep;
    S.a_ready(cur);
    if constexpr (SP2) {
        PG8_STAGE(PG8_SB(0, 0), cB, voffB); PG8_STAGE(PG8_SB(0, 1), cB + hstep, voffB); PG8_STAGE(PG8_SA(0, 0), cA, voffA); PG8_STAGE(PG8_SA(0, 1), cA + hstep, voffA);
        if (wr == 1) PG8_BAR;
        PG8_WAIT_V(2); PG8_BAR;
        PG8_STAGE(PG8_SB(1, 0), cB + kstep, voffB); PG8_STAGE(PG8_SA(1, 0), cA + kstep, voffA); PG8_STAGE(PG8_SB(1, 1), cB + hstep + kstep, voffB);
        PG8_WAIT_V(6); PG8_BAR;
    } else {
        PG8_STAGE(PG8_SB(0, 0), cB, voffB); PG8_STAGE(PG8_SA(0, 0), cA, voffA); PG8_STAGE(PG8_SB(0, 1), cB + hstep, voffB); PG8_STAGE(PG8_SA(0, 1), cA + hstep, voffA);
        if (wr == 1) PG8_BAR;
        PG8_WAIT_V(4); PG8_BAR;
        PG8_STAGE(PG8_SB(1, 0), cB + kstep, voffB); PG8_STAGE(PG8_SA(1, 0), cA + kstep, voffA); PG8_STAGE(PG8_SB(1, 1), cB + hstep + kstep, voffB);
        PG8_WAIT_V(6); PG8_BAR;
    }
    for (;;) {
        const bool has_next = S.next(ui + 1, nxt);
        const char* nA = has_next ? (const char*)(nxt.sel ? g.A2 : g.A) + (size_t)nxt.pm * tstep : cA; const char* nB = has_next ? (const char*)(nxt.sel ? g.Bt2 : g.Bt) + (size_t)nxt.pn * tstep : cB;
        for (int t = 0; t < nt; t += 2) {
            const bool last = (t == nt - 2);
            const char* a1 = cA + (size_t)(t + 1) * kstep;
            const char* a2 = last ? nA : cA + (size_t)(t + 2) * kstep; const char* b2 = last ? nB : cB + (size_t)(t + 2) * kstep;
            const char* a3 = a2 + kstep; const char* b3 = b2 + kstep;
            if (last && has_next) S.a_ready(nxt);
            if constexpr (SP2) {
            PG8_LDB(B0, 0, 0); PG8_LDB(B1, 0, 1); PG8_SCHED; PG8_LDA(At, 0, 0); PG8_STAGE(PG8_SA(1, 1), a1 + hstep, voffA);
            PG8_WAIT_V(8); PG8_WAIT_L(0); PG8_BAR; PG8_MMA(0, 0, At, B0); PG8_MMA(0, 1, At, B1); PG8_BAR; PG8_SCHED;
            PG8_LDA(At, 0, 1); PG8_STAGE(PG8_SB(0, 0), b2, voffB); PG8_STAGE(PG8_SB(0, 1), b2 + hstep, voffB); PG8_STAGE(PG8_SA(0, 0), a2, voffA);
            PG8_WAIT_V(8); PG8_WAIT_L(0); PG8_BAR; PG8_MMA(1, 0, At, B0); PG8_MMA(1, 1, At, B1); PG8_BAR; PG8_SCHED;
            PG8_LDB(B0, 1, 0); PG8_LDB(B1, 1, 1); PG8_SCHED; PG8_LDA(At, 1, 0); PG8_STAGE(PG8_SA(0, 1), a2 + hstep, voffA);
            PG8_WAIT_V(8); PG8_WAIT_L(0); PG8_BAR; PG8_MMA(0, 0, At, B0); PG8_MMA(0, 1, At, B1); PG8_BAR; PG8_SCHED;
            PG8_LDA(At, 1, 1); PG8_STAGE(PG8_SB(1, 0), b3, voffB); PG8_STAGE(PG8_SB(1, 1), b3 + hstep, voffB); PG8_STAGE(PG8_SA(1, 0), a3, voffA);
            PG8_WAIT_V(8); PG8_WAIT_L(0); PG8_BAR; PG8_MMA(1, 0, At, B0); PG8_MMA(1, 1, At, B1); PG8_BAR; PG8_SCHED;
            } else {
            PG8_LDB(B0, 0, 0); PG8_SCHED; PG8_LDA(At, 0, 0); PG8_STAGE(PG8_SA(1, 1), a1 + hstep, voffA);
            PG8_WAIT_L(8); PG8_BAR; PG8_WAIT_L(0); PG8_MMA(0, 0, At, B0); PG8_BAR; PG8_SCHED;
            PG8_LDB(B1, 0, 1); PG8_STAGE(PG8_SB(0, 0), b2, voffB);
            PG8_BAR; PG8_WAIT_L(0); PG8_MMA(0, 1, At, B1); PG8_BAR;
            PG8_LDA(At, 0, 1); PG8_STAGE(PG8_SA(0, 0), a2, voffA);
            PG8_BAR; PG8_WAIT_L(0); PG8_MMA(1, 0, At, B0); PG8_BAR; PG8_SCHED;
            PG8_STAGE(PG8_SB(0, 1), b2 + hstep, voffB);
            PG8_WAIT_V(6); PG8_BAR; PG8_MMA(1, 1, At, B1); PG8_BAR;
            PG8_LDB(B0, 1, 0); PG8_SCHED; PG8_LDA(At, 1, 0); PG8_STAGE(PG8_SA(0, 1), a2 + hstep, voffA);
            PG8_WAIT_L(8); PG8_BAR; PG8_WAIT_L(0); PG8_MMA(0, 0, At, B0); PG8_BAR; PG8_SCHED;
            PG8_LDB(B1, 1, 1); PG8_STAGE(PG8_SB(1, 0), b3, voffB);
            PG8_BAR; PG8_WAIT_L(0); PG8_MMA(0, 1, At, B1); PG8_BAR;
            PG8_LDA(At, 1, 1); PG8_STAGE(PG8_SA(1, 0), a3, voffA);
            PG8_BAR; PG8_WAIT_L(0); PG8_MMA(1, 0, At, B0); PG8_BAR; PG8_SCHED;
            PG8_STAGE(PG8_SB(1, 1), b3 + hstep, voffB);
            PG8_WAIT_V(6); PG8_BAR; PG8_MMA(1, 1, At, B1); PG8_BAR;
            }
        }
        if constexpr (ALIGN_EPI) { if (wr == 0) PG8_BAR; }
        if constexpr (!Epi::AFTER_DRAIN) { E(acc, cur, wr, wc, fr, fq); S.done(cur); }
        if (!has_next) break;
#pragma unroll
        for (int a = 0; a < 2; ++a)
#pragma unroll
            for (int b = 0; b < 2; ++b)
#pragma unroll
                for (int m = 0; m < 4; ++m)
#pragma unroll
                    for (int n = 0; n < 2; ++n) acc[a][b][m][n] = (f32x4){0.f, 0.f, 0.f, 0.f};
        cur = nxt; cA = nA; cB = nB; ++ui;
        if constexpr (ALIGN_EPI) { if (wr == 1) PG8_BAR; }
    }
    PG8_WAIT_V(0);
    if constexpr (!ALIGN_EPI) { if (wr == 0) PG8_BAR; }
    PG8_BAR;
    if constexpr (Epi::AFTER_DRAIN) { E.fused(acc, cur, wr, wc, fr, fq, lds, wid, lane); S.done(cur); }
#undef PG8_SA
#undef PG8_SB
#undef PG8_STAGE
#undef PG8_LDA
#undef PG8_LDB
#undef PG8_MMA
#undef PG8_WAIT_V
#undef PG8_WAIT_L
#undef PG8_BAR
#undef PG8_SCHED
}
}
constexpr int NWAVES = 8;
constexpr int D = 2048, NTOK = 32768, NPROMPT = 16384, SEQP = 4096, DB = 1024, DIN = 12288;
constexpr size_t MiB = 1u << 20;
constexpr size_t WS_MODP = 0, WS_GATE = 1 * MiB, WS_BAR = 1280 * 1024;
constexpr size_t WS_WIN = 2 * MiB, WS_WPA = 50 * MiB, WS_WPB = 54 * MiB, WS_WO = 58 * MiB;
constexpr size_t WS_GA = 66 * MiB, WS_Q = 130 * MiB, WS_K = 194 * MiB, WS_V = 258 * MiB, WS_SBZ = 322 * MiB, WS_U = 386 * MiB, WS_END = 578 * MiB;
constexpr size_t WS_SGA = 450 * MiB, OUT_G8A = 128 * MiB, OUT_G8B = 192 * MiB;
constexpr int RING_BYTES = 131072, BIAS_OFF = 131072, LDS_BYTES = 131072 + 8192;
typedef unsigned short bf16;
typedef unsigned v4u __attribute__((ext_vector_type(4)));
typedef unsigned v2u __attribute__((ext_vector_type(2)));
typedef float f32x4 __attribute__((ext_vector_type(4)));
typedef short bf16x8 __attribute__((ext_vector_type(8)));
typedef short s16x4 __attribute__((ext_vector_type(4)));
#define LAS __attribute__((address_space(3)))
__device__ __forceinline__ unsigned f2bf(float f) { unsigned u = __builtin_bit_cast(unsigned, f); return (u + 0x7fffu + ((u >> 16) & 1u)) >> 16; }
__device__ __forceinline__ unsigned pk2(float lo, float hi) { return pg8::cvt_pk_bf16(lo, hi); }
__device__ __forceinline__ float wave_sum(float v) {
#pragma unroll
    for (int o = 1; o < 64; o <<= 1) v += __shfl_xor(v, o);
    return v;
}
struct Args { const float* in[16]; float* out; unsigned char* ws; int ph_lo, ph_hi; };

template <int MODE> __device__ __forceinline__ int dest_row(int s) {
    if (MODE == 1 && s < 4096) { const int kind = s >> 10, ch = s & 1023, tile = ch >> 6, chl = ch & 63; return tile * 256 + 128 * (kind >> 1) + 32 * (chl >> 4) + 16 * (kind & 1) + (chl & 15); }
    const int cl = s & 255;
    if (MODE == 2) return (s & ~255) + 128 * ((cl >> 5) & 1) + 32 * (cl >> 6) + 16 * ((cl >> 4) & 1) + 4 * ((cl >> 2) & 3) + (cl & 3);
    return (s & ~255) + 128 * ((cl >> 5) & 1) + 32 * (cl >> 6) + 16 * ((cl >> 2) & 1) + 4 * ((cl >> 3) & 3) + (cl & 3);
}
template <int MODE> __device__ __forceinline__ void p0_transpose_item(const float* W, int K, int N, bf16* WT, LAS float* scr, int item, int lane) {
    const int nblk = N / 32, kb = item / nblk, nb = item % nblk, k0 = 64 * kb, n0 = 32 * nb;
#pragma unroll 8
    for (int i = 0; i < 32; ++i) { const int kk = 2 * i + (lane >> 5); scr[kk * 33 + (lane & 31)] = W[(size_t)(k0 + kk) * N + n0 + (lane & 31)]; }
    asm volatile("s_waitcnt lgkmcnt(0)" ::: "memory");
    const int c = lane & 7;
#pragma unroll
    for (int j = 0; j < 4; ++j) { const int n = (lane >> 3) + 8 * j; const LAS float* s = scr + (8 * c) * 33 + n;
        v4u o;
        if (MODE == 1) { o.x = pg8::cvt_pk_rbf16(s[0 * 33], s[1 * 33]); o.y = pg8::cvt_pk_rbf16(s[2 * 33], s[3 * 33]); o.z = pg8::cvt_pk_rbf16(s[4 * 33], s[5 * 33]); o.w = pg8::cvt_pk_rbf16(s[6 * 33], s[7 * 33]); }
        else { o.x = pk2(s[0 * 33], s[1 * 33]); o.y = pk2(s[2 * 33], s[3 * 33]); o.z = pk2(s[4 * 33], s[5 * 33]); o.w = pk2(s[6 * 33], s[7 * 33]); }
        *(v4u*)(WT + (size_t)dest_row<MODE>(n0 + n) * K + k0 + 8 * c) = o; }
    asm volatile("s_waitcnt lgkmcnt(0)" ::: "memory");
}
__device__ __forceinline__ void p0_item(const Args& a, LAS float* scr, int it, int lane) {
    unsigned char* ws = a.ws;
    constexpr int I_IN = (D / 64) * (DIN / 32), I_P = (DB / 64) * (D / 32), I_O = (D / 64) * (D / 32);
    if (it < I_IN) { p0_transpose_item<1>(a.in[7], D, DIN, (bf16*)(ws + WS_WIN), scr, it, lane); return; } it -= I_IN;
    if (it < I_P) { p0_transpose_item<0>(a.in[13], DB, D, (bf16*)(ws + WS_WPA), scr, it, lane); return; } it -= I_P;
    if (it < I_P) { p0_transpose_item<0>(a.in[14], DB, D, (bf16*)(ws + WS_WPB), scr, it, lane); return; } it -= I_P;
    if (it < I_O) p0_transpose_item<2>(a.in[15], D, D, (bf16*)(ws + WS_WO), scr, it, lane);
}
__device__ __forceinline__ void p0_phase(const Args& a, LAS unsigned char* lds, int tid, int lane, int wave, int G) {
    const float* cp = a.in[2]; const float* csm = a.in[3]; const float* wada = a.in[5];
    float* modp = (float*)(a.ws + WS_MODP);
    LAS float* sc = (LAS float*)lds; LAS float* red = (LAS float*)(lds + 8192);
    for (int task = blockIdx.x; task < 192; task += G) {
        const int cgi = task % 24, ks = task / 24;
        for (int e = tid; e < 1280; e += 512) { const int b = e >> 8, kk = e & 255; const float cv = b < 4 ? cp[b * D + ks * 256 + kk] : csm[ks * 256 + kk]; sc[e] = cv * pg8::fsigmoid(cv); }
        __syncthreads();
        const int k0 = ks * 256 + wave * 32, n = cgi * 256 + lane * 4;
        f32x4 ac[5];
#pragma unroll
        for (int b = 0; b < 5; ++b) ac[b] = (f32x4){0.f, 0.f, 0.f, 0.f};
#pragma unroll 8
        for (int kk = 0; kk < 32; ++kk) { const f32x4 wv = *(const f32x4*)(wada + (size_t)(k0 + kk) * 6144 + n);
#pragma unroll
            for (int b = 0; b < 5; ++b) ac[b] += wv * sc[b * 256 + wave * 32 + kk]; }
#pragma unroll
        for (int b = 0; b < 5; ++b)
#pragma unroll
            for (int j = 0; j < 4; ++j) red[(wave * 20 + b * 4 + j) * 64 + lane] = ac[b][j];
        __syncthreads();
        for (int e = tid; e < 1280; e += 512) { const int q = e >> 6, l = e & 63; float s = 0.f;
#pragma unroll
            for (int w = 0; w < 8; ++w) s += red[(w * 20 + q) * 64 + l];
            modp[(size_t)(ks * 5 + (q >> 2)) * 6144 + cgi * 256 + l * 4 + (q & 3)] = s; }
        __syncthreads();
    }
}
__device__ __forceinline__ void p0_copy_phase(const Args& a, LAS unsigned char* lds, int lane, int wave, int G) {
    LAS float* scr = (LAS float*)(lds + wave * 16384);
    for (int it = blockIdx.x * NWAVES + wave; it < 16384; it += G * NWAVES) p0_item(a, scr, it, lane);
}
__device__ __forceinline__ void p1_phase(const Args& a, LAS unsigned char* lds, int tid, int lane, int wave, int G) {
    const float* modp = (const float*)(a.ws + WS_MODP); const float* bada = a.in[6]; const float* ng = a.in[4];
    float* gate = (float*)(a.ws + WS_GATE); bf16* H = (bf16*)a.out;
    LAS f32x4* mS = (LAS f32x4*)lds; LAS f32x4* mB = (LAS f32x4*)(lds + 8192);
    for (int rb = blockIdx.x; rb < NTOK / 128; rb += G) {
        const int row0 = rb * 128, b = row0 < NPROMPT ? row0 / SEQP : 4;
        __syncthreads();
        { const int k4 = tid * 4; f32x4 sh = *(const f32x4*)(bada + k4), sl = *(const f32x4*)(bada + 2048 + k4), gt = *(const f32x4*)(bada + 4096 + k4);
#pragma unroll
          for (int ks = 0; ks < 8; ++ks) { const float* mp = modp + (size_t)(ks * 5 + b) * 6144 + k4; sh += *(const f32x4*)mp; sl += *(const f32x4*)(mp + 2048); gt += *(const f32x4*)(mp + 4096); }
          mS[tid] = *(const f32x4*)(ng + k4) * (sl + 1.0f); mB[tid] = sh;
          if ((row0 & (SEQP - 1)) == 0 && (row0 <= NPROMPT)) *(f32x4*)(gate + b * 2048 + k4) = gt; }
        __syncthreads();
        for (int i = 0; i < 16; ++i) { const int row = row0 + wave * 16 + i;
            const float* xr = row < NPROMPT ? a.in[0] + (size_t)row * D : a.in[1] + (size_t)(row - NPROMPT) * D;
            f32x4 v[8]; float ss = 0.f;
#pragma unroll
            for (int j = 0; j < 8; ++j) { v[j] = *(const f32x4*)(xr + 4 * lane + 256 * j); ss += (v[j][0] * v[j][0] + v[j][1] * v[j][1]) + (v[j][2] * v[j][2] + v[j][3] * v[j][3]); }
            const float rstd = 1.0f / sqrtf(wave_sum(ss) * (1.0f / D) + 1e-6f);
            bf16* hr = H + (size_t)row * D + 4 * lane;
#pragma unroll
            for (int j = 0; j < 8; ++j) { const f32x4 o = v[j] * rstd * mS[lane + 64 * j] + mB[lane + 64 * j]; v2u w; w.x = pg8::cvt_pk_rbf16(o[0], o[1]); w.y = pg8::cvt_pk_rbf16(o[2], o[3]); *(v2u*)(hr + 256 * j) = w; } }
    }
}
__device__ __forceinline__ void conv_phase(const Args& a, int tid, int G) {
    const bf16* U = (const bf16*)(a.ws + WS_U); bf16* GA = (bf16*)(a.ws + WS_GA);
    const float* cw = a.in[8]; const float* cb = a.in[9];
    const size_t gt = (size_t)blockIdx.x * 512 + tid, nthr = (size_t)G * 512;
    const int c8 = (int)(gt & 127) * 8;
    f32x4 w0a = *(const f32x4*)(cw + c8), w0b = *(const f32x4*)(cw + c8 + 4), w1a = *(const f32x4*)(cw + 1024 + c8), w1b = *(const f32x4*)(cw + 1024 + c8 + 4);
    f32x4 w2a = *(const f32x4*)(cw + 2048 + c8), w2b = *(const f32x4*)(cw + 2048 + c8 + 4), ba = *(const f32x4*)(cb + c8), bb = *(const f32x4*)(cb + c8 + 4);
    const bf16* __restrict__ Ur = U; bf16* __restrict__ GAw = GA;
    const v4u z = (v4u){0u, 0u, 0u, 0u};
    v4u um, u0, up, g;
    { const int tok = (int)(gt >> 7); const int tl = tok < NPROMPT ? (tok & (SEQP - 1)) : tok - NPROMPT, L = tok < NPROMPT ? SEQP : NTOK - NPROMPT; const size_t off = (size_t)tok * 1024 + c8;
      um = tl > 0 ? *(const v4u*)(Ur + off - 1024) : z; u0 = *(const v4u*)(Ur + off); up = tl < L - 1 ? *(const v4u*)(Ur + off + 1024) : z; g = *(const v4u*)(GAw + off); }
    for (size_t idx = gt; idx < (size_t)NTOK * 128; idx += nthr) {
        const size_t off = (size_t)(idx >> 7) * 1024 + c8;
        v4u num = z, nu0 = z, nup = z, ng = z; const size_t nidx = idx + nthr;
        if (nidx < (size_t)NTOK * 128) { const int tok = (int)(nidx >> 7); const int tl = tok < NPROMPT ? (tok & (SEQP - 1)) : tok - NPROMPT, L = tok < NPROMPT ? SEQP : NTOK - NPROMPT; const size_t noff = (size_t)tok * 1024 + c8;
            num = tl > 0 ? *(const v4u*)(Ur + noff - 1024) : z; nu0 = *(const v4u*)(Ur + noff); nup = tl < L - 1 ? *(const v4u*)(Ur + noff + 1024) : z; ng = *(const v4u*)(GAw + noff); }
        f32x4 ma, mb, ca, cbv, pa, pb, ga, gb;
        pg8::unpack8(um, ma, mb); pg8::unpack8(u0, ca, cbv); pg8::unpack8(up, pa, pb); pg8::unpack8(g, ga, gb);
        const f32x4 ya = ga * (ma * w0a + ca * w1a + pa * w2a + ba) * 0.25f, yb = gb * (mb * w0b + cbv * w1b + pb * w2b + bb) * 0.25f;
        *(v4u*)(GAw + off) = pg8::pack8(ya, yb);
        um = num; u0 = nu0; up = nup; g = ng;
    }
}
__device__ __forceinline__ s16x4 vtr(const LAS unsigned char* p) { return __builtin_bit_cast(s16x4, __builtin_amdgcn_ds_read_tr16_b64_v4i16((LAS s16x4*)p)); }
__device__ __forceinline__ void attn_phase(const Args& a, LAS unsigned char* lds, int tid, int lane, int wave, int vcu, int G) {
    bf16* Q = (bf16*)(a.ws + WS_Q); const bf16* Kb = (const bf16*)(a.ws + WS_K); const bf16* V = (const bf16*)(a.ws + WS_V); const bf16* SBZ = (const bf16*)(a.ws + WS_SBZ);
    const float* rpb = a.in[12];
    const int fr = lane & 15, fq = lane >> 4, hh = wave >> 2, j = wave & 3;
    const int cwin0 = j == 0 ? 0 : (j == 1 ? 8 : (j == 2 ? 24 : 32));
    const int qcol = 16 * j + fr; const int cs = min(max(qcol - 8, 0), 48);
    const int kc0 = cwin0 + 4 * fq - cs;
    const int dcb = cwin0 + 4 * fq - qcol + 15 + 16;
    LAS unsigned char* vimg = lds + hh * 65536;
    LAS float* bimg = (LAS float*)(lds + BIAS_OFF) + hh * 960;
    bool sel[4]; int bofs[4];
#pragma unroll
    for (int e = 0; e < 4; ++e) { sel[e] = (kc0 + e) >= 0; bofs[e] = dcb + (sel[e] ? e : 16 + e); }
    const int vtok = tid >> 4, vc16 = tid & 15, vc = vc16 & 7;
    for (int chunk = vcu; chunk < 256; chunk += G) {
        const int hp = chunk >> 5, crow = chunk & 31;
        int tokbase, r0, R; if (crow < 16) { tokbase = (crow >> 2) * SEQP; r0 = (crow & 3) * 16; R = 64; } else { tokbase = NPROMPT; r0 = (crow - 16) * 16; R = 256; }
        const int h = 2 * hp + hh;
        const bf16* vbase = V + (size_t)tokbase * 1024 + hp * 128 + vc16 * 8;
        const int rs0 = min(max(r0 - 4, 0), R - 8);
        { v4u vt[16];
#pragma unroll
          for (int p = 0; p < 16; ++p) { const int t = vtok + 32 * p; vt[p] = *(const v4u*)(vbase + (size_t)(rs0 * 64 + t) * 1024); }
          float bv[2];
#pragma unroll
          for (int p = 0; p < 2; ++p) { const int e = tid + 512 * p; bv[p] = e < 930 ? rpb[2 * hp * 465 + e] : 0.f; }
          __syncthreads();
#pragma unroll
          for (int p = 0; p < 16; ++p) { const int t = vtok + 32 * p, tok = (((rs0 + (t >> 6)) & 7) << 6) + (t & 63);
              *(LAS v4u*)(lds + (vc16 >> 3) * 65536 + 128 * tok + 32 * ((vc >> 1) ^ ((tok >> 1) & 3)) + 16 * (vc & 1)) = vt[p]; }
#pragma unroll
          for (int p = 0; p < 2; ++p) { const int e = tid + 512 * p; if (e < 930) { const int h2 = e >= 465 ? 1 : 0, rem = e - 465 * h2, dr = rem / 31, dc = rem - 31 * dr;
              ((LAS float*)(lds + BIAS_OFF))[h2 * 960 + dr * 64 + dc + 16] = bv[p] * 1.4426950408889634f; } }
          __syncthreads(); }
        int qtok = tokbase + r0 * 64 + 16 * j + fr;
        bf16x8 qf0 = *(const bf16x8*)(Q + (size_t)qtok * 1024 + h * 64 + 8 * fq), qf1 = *(const bf16x8*)(Q + (size_t)qtok * 1024 + h * 64 + 8 * fq + 32);
        v2u zz[4];
#pragma unroll
        for (int n = 0; n < 4; ++n) zz[n] = *(const v2u*)(SBZ + (size_t)qtok * 1024 + h * 64 + 4 * fq + 16 * n);
#pragma unroll 1
        for (int it = 0; it < 16; ++it) {
            const int r = r0 + it, rs = min(max(r - 4, 0), R - 8);
            const int rsn = min(max(r + 1 - 4, 0), R - 8); const bool more = it < 15, newrow = more && (rsn != rs);
            v4u nv[2]; bf16x8 nq0, nq1; v2u nz[4];
            if (newrow) {
#pragma unroll
                for (int p = 0; p < 2; ++p) nv[p] = *(const v4u*)(vbase + (size_t)((rsn + 7) * 64 + vtok + 32 * p) * 1024); }
            const int qtokn = qtok + 64;
            if (more) { nq0 = *(const bf16x8*)(Q + (size_t)qtokn * 1024 + h * 64 + 8 * fq); nq1 = *(const bf16x8*)(Q + (size_t)qtokn * 1024 + h * 64 + 8 * fq + 32);
#pragma unroll
                for (int n = 0; n < 4; ++n) nz[n] = *(const v2u*)(SBZ + (size_t)qtokn * 1024 + h * 64 + 4 * fq + 16 * n); }
            f32x4 s[8][2];
            const bf16* kp = Kb + (size_t)(tokbase + rs * 64 + cwin0 + fr) * 1024 + h * 64 + 8 * fq;
#pragma unroll
            for (int i = 0; i < 8; ++i)
#pragma unroll
                for (int b = 0; b < 2; ++b) { const bf16* kq = kp + (size_t)(i * 64 + 16 * b) * 1024;
                    const bf16x8 kf0 = *(const bf16x8*)kq, kf1 = *(const bf16x8*)(kq + 32);
                    f32x4 acc = (f32x4){0.f, 0.f, 0.f, 0.f};
                    acc = pg8::mfma16(kf0, qf0, acc);
                    acc = pg8::mfma16(kf1, qf1, acc);
                    s[i][b] = acc; }
            float mx = -1e30f; float sv[8][4];
#pragma unroll
            for (int i = 0; i < 8; ++i) { const LAS float* brow = bimg + (rs + i - r + 7) * 64;
#pragma unroll
                for (int e = 0; e < 4; ++e) { const float v = (sel[e] ? s[i][0][e] : s[i][1][e]) + brow[bofs[e]]; sv[i][e] = v; mx = fmaxf(mx, v); } }
            mx = fmaxf(mx, __shfl_xor(mx, 16)); mx = fmaxf(mx, __shfl_xor(mx, 32));
            float sum = 0.f; bf16x8 pf[8];
#pragma unroll
            for (int i = 0; i < 8; ++i) { float p0[4], p1[4];
#pragma unroll
                for (int e = 0; e < 4; ++e) { const float pv = __builtin_amdgcn_exp2f(sv[i][e] - mx); sum += pv; p0[e] = sel[e] ? pv : 0.f; p1[e] = sel[e] ? 0.f : pv; }
                v4u w; w.x = pg8::cvt_pk_bf16(p0[0], p0[1]); w.y = pg8::cvt_pk_bf16(p0[2], p0[3]); w.z = pg8::cvt_pk_bf16(p1[0], p1[1]); w.w = pg8::cvt_pk_bf16(p1[2], p1[3]);
                pf[i] = __builtin_bit_cast(bf16x8, w); }
            sum += __shfl_xor(sum, 16); sum += __shfl_xor(sum, 32);
            f32x4 o[4];
#pragma unroll
            for (int n = 0; n < 4; ++n) o[n] = (f32x4){0.f, 0.f, 0.f, 0.f};
#pragma unroll
            for (int i = 0; i < 8; ++i) { const int k0 = (((rs + i) & 7) << 6) + cwin0 + 4 * fq + (fr >> 2), k1 = k0 + 16;
#pragma unroll
                for (int n = 0; n < 4; ++n) {
                    const s16x4 t0 = vtr(vimg + 128 * k0 + 32 * (n ^ ((k0 >> 1) & 3)) + 8 * (fr & 3));
                    const s16x4 t1 = vtr(vimg + 128 * k1 + 32 * (n ^ ((k1 >> 1) & 3)) + 8 * (fr & 3));
                    const bf16x8 vf = (bf16x8){t0[0], t0[1], t0[2], t0[3], t1[0], t1[1], t1[2], t1[3]};
                    o[n] = pg8::mfma16(vf, pf[i], o[n]); } }
            const float inv = 1.0f / sum;
            const size_t ob = (size_t)qtok * 1024 + h * 64 + 4 * fq;
#pragma unroll
            for (int n = 0; n < 4; ++n) { const v2u z = zz[n];
                v2u w; w.x = pg8::cvt_pk_bf16(o[n][0] * inv * pg8::bf_lo(z.x), o[n][1] * inv * pg8::bf_hi(z.x)); w.y = pg8::cvt_pk_bf16(o[n][2] * inv * pg8::bf_lo(z.y), o[n][3] * inv * pg8::bf_hi(z.y));
                *(v2u*)(Q + ob + 16 * n) = w; }
            if (newrow) {
                __syncthreads();
#pragma unroll
                for (int p = 0; p < 2; ++p) { const int tok = (((rsn + 7) & 7) << 6) + vtok + 32 * p;
                    *(LAS v4u*)(lds + (vc16 >> 3) * 65536 + 128 * tok + 32 * ((vc >> 1) ^ ((tok >> 1) & 3)) + 16 * (vc & 1)) = nv[p]; }
                __syncthreads(); }
            if (more) { qf0 = nq0; qf1 = nq1;
#pragma unroll
                for (int n = 0; n < 4; ++n) zz[n] = nz[n]; }
            qtok = qtokn;
        }
    }
}
#define XB_TMO      128
#define XB_XCNT(j)  (256  + 64 * (j))
#define XB_XSUB(j)  (1280 + 64 * (j))
#define XB_XGEN(j)  (2304 + 64 * (j))
#define XB_TOP      3328
#define XB_TOPGEN   3392
#define XCD_BAR_WORDS 3456
#define XB_SPIN_CAP (1u << 18)

__device__ __forceinline__ unsigned xb_ld(unsigned* p)              { return __hip_atomic_load(p, __ATOMIC_RELAXED, __HIP_MEMORY_SCOPE_AGENT); }
__device__ __forceinline__ unsigned xb_add(unsigned* p, unsigned v) { return __hip_atomic_fetch_add(p, v, __ATOMIC_RELAXED, __HIP_MEMORY_SCOPE_AGENT); }
__device__ __forceinline__ unsigned xb_xcc_id() { return (unsigned)__builtin_amdgcn_s_getreg((3 << 11) | 20) & 0xFu; }
#define XB_SPIN(cond, bar) do { unsigned _sp = 0; while (cond) { __builtin_amdgcn_s_sleep(1); \
    if ((++_sp & 255u) == 0u) { if (xb_ld(&(bar)[XB_TMO])) break; if (_sp > XB_SPIN_CAP) { atomicAdd(&(bar)[XB_TMO], 1u); break; } } } } while (0)

struct XcdBarrier {
    unsigned* bar; unsigned x;
    volatile LAS unsigned* st;
};

__device__ __forceinline__ XcdBarrier xcd_barrier_post(unsigned* bar, volatile LAS unsigned* st) {
    XcdBarrier b; b.bar = bar; b.x = xb_xcc_id(); b.st = st;
    if (threadIdx.x == 0) (void)xb_add(&bar[XB_XCNT(b.x)], 1u);
    return b;
}
__device__ __forceinline__ void xcd_barrier_complete(unsigned* bar, unsigned x, unsigned& nloc, unsigned& nx) {
    const unsigned G = gridDim.x * gridDim.y * gridDim.z;
    unsigned sum, cnt, mine, sp = 0u;
    for (;;) {
        sum = 0u; cnt = 0u; mine = 0u;
#pragma unroll
        for (unsigned j = 0; j < 16; ++j) { const unsigned c = xb_ld(&bar[XB_XCNT(j)]); sum += c; cnt += (c > 0u) ? 1u : 0u; mine = (j == x) ? c : mine; }
        if (sum == G) break;
        __builtin_amdgcn_s_sleep(1);
        if ((++sp & 255u) == 0u) { if (xb_ld(&bar[XB_TMO])) break; if (sp > XB_SPIN_CAP) { atomicAdd(&bar[XB_TMO], 1u); break; } }
    }
    nloc = mine > 0u ? mine : 1u; nx = cnt > 0u ? cnt : 1u;
}

__device__ __forceinline__ void xcd_barrier(const XcdBarrier& b) {
    asm volatile("s_waitcnt vmcnt(0)" ::: "memory");
    __syncthreads();
    if (threadIdx.x == 0) {
        unsigned* bar = b.bar;
        __builtin_amdgcn_s_waitcnt(0);
        unsigned nloc = b.st[0], nx = b.st[1];
        if (nloc == 0u) { xcd_barrier_complete(bar, b.x, nloc, nx); b.st[0] = nloc; b.st[1] = nx; }
        const unsigned old = xb_add(&bar[XB_XSUB(b.x)], 1u);
        const unsigned gen = old / nloc;
        if (old + 1u == (gen + 1u) * nloc) {
            __builtin_amdgcn_fence(__ATOMIC_RELEASE, "agent");
            asm volatile("s_waitcnt vmcnt(0)" ::: "memory");
            const unsigned og = xb_add(&bar[XB_TOP], 1u);
            const unsigned tg = og / nx;
            if (og + 1u == (tg + 1u) * nx) xb_add(&bar[XB_TOPGEN], 1u);
            else XB_SPIN(xb_ld(&bar[XB_TOPGEN]) == tg, bar);
            __builtin_amdgcn_fence(__ATOMIC_ACQUIRE, "agent");
            xb_add(&bar[XB_XGEN(b.x)], 1u);
            asm volatile("s_waitcnt vmcnt(0)" ::: "memory");
        } else {
            XB_SPIN(xb_ld(&bar[XB_XGEN(b.x)]) == gen, bar);
            __builtin_amdgcn_fence(__ATOMIC_ACQUIRE, "agent");
            asm volatile("s_waitcnt vmcnt(0)" ::: "memory");
        }
    }
    __syncthreads();
}

#ifndef MK_N_LAUNCHES
#define MK_N_LAUNCHES 1
#endif
constexpr int NPHASE = 6;
__global__ void __launch_bounds__(NWAVES * 64, 2) hybrid_fwd(Args args) {
    extern __shared__ __attribute__((aligned(16))) unsigned char lds_raw[];
    LAS unsigned char* lds = (LAS unsigned char*)lds_raw;
    const int tid = threadIdx.x, lane = tid & 63, wave = __builtin_amdgcn_readfirstlane(tid >> 6);
    const int G = gridDim.x, bx = blockIdx.x, vcu = (G % 8 == 0) ? (bx % 8) * (G / 8) + bx / 8 : bx;
    unsigned char* ws = args.ws;
    const int lo = args.ph_lo, hi = args.ph_hi;
#define IN(k) (lo <= (k) && (k) < hi)
#define SEAM(k) do { if (IN(k) && IN((k) + 1)) { xcd_barrier(xbar); } } while (0)
    bf16* H = (bf16*)args.out;
    volatile LAS unsigned* xst = (volatile LAS unsigned*)(lds + BIAS_OFF + 7936);
    if (tid < 2) xst[tid] = 0u;
    __syncthreads();
    const XcdBarrier xbar = xcd_barrier_post((unsigned*)(ws + WS_BAR), xst);
    if (lo < 0) cg::this_grid().sync();
    if (IN(0)) { p0_phase(args, lds, tid, lane, wave, G); }
    SEAM(0);
    if (IN(1)) { p1_phase(args, lds, tid, lane, wave, G); __syncthreads(); p0_copy_phase(args, lds, lane, wave, G); }
    SEAM(1);
    if (IN(2)) {
        __syncthreads();
        pg8::Gemm g{H, (const bf16*)(ws + WS_WIN), NTOK, DIN, D}; pg8::StaticOrder S; S.init(NTOK, DIN, G, bx);
        pg8::EpiIn E{(bf16*)(ws + WS_U), (bf16*)(ws + WS_GA), (bf16*)(ws + WS_Q), (bf16*)(ws + WS_K), (bf16*)(ws + WS_V), (bf16*)(ws + WS_SBZ), args.in[10], args.in[11], (bf16*)((unsigned char*)args.out + OUT_G8A), (bf16*)((unsigned char*)args.out + OUT_G8B)};
        pg8::gemm_phase<pg8::EpiIn, pg8::StaticOrder, true, true, true>(lds, g, S, E);
    }
    SEAM(2);
    if (IN(3)) { conv_phase(args, tid, G); attn_phase(args, lds, tid, lane, wave, vcu, G); }
    SEAM(3);
    if (IN(4)) {
        __syncthreads();
        pg8::Gemm g{(const bf16*)(ws + WS_GA), (const bf16*)(ws + WS_WPA), NTOK, D, DB, (const bf16*)(ws + WS_Q), (const bf16*)(ws + WS_WPB)}; pg8::PairOrder S; S.init(NTOK, D, G, bx);
        pg8::EpiMerge2 E{(bf16*)(ws + WS_SGA), (const unsigned char*)args.out + OUT_G8A, (const unsigned char*)args.out + OUT_G8B};
        pg8::gemm_phase<pg8::EpiMerge2, pg8::PairOrder, true, true>(lds, g, S, E);
    }
    SEAM(4);
    if (IN(5)) {
        __syncthreads();
        pg8::Gemm g{(const bf16*)(ws + WS_SGA), (const bf16*)(ws + WS_WO), NTOK, D, D}; pg8::StaticOrder S; S.init(NTOK, D, G, bx);
        pg8::EpiOut E{args.in[0], args.in[1], (const float*)(ws + WS_GATE), args.out};
        pg8::gemm_phase<pg8::EpiOut, pg8::StaticOrder, true, true>(lds, g, S, E);
    }
#undef IN
#undef SEAM
}

extern "C" void kernel_launch(void* const* d_in, const int* in_sizes, int n_in, void* d_out, int out_size, void* d_ws, size_t ws_size, hipStream_t stream) {
    static int grid = 0;
    if (grid == 0) {
        if (n_in != 16 || in_sizes[0] != NPROMPT * D || out_size != NTOK * D || ws_size < WS_END) { fprintf(stderr, "kernel_launch: unexpected shapes (n_in %d, in0 %d, out %d, ws %zu)\n", n_in, n_in > 0 ? in_sizes[0] : -1, out_size, ws_size); grid = -1; return; }
        int dev = 0, cus = 0, per_cu = 0;
        hipGetDevice(&dev); hipDeviceGetAttribute(&cus, hipDeviceAttributeMultiprocessorCount, dev);
        if (hipFuncSetAttribute((const void*)hybrid_fwd, hipFuncAttributeMaxDynamicSharedMemorySize, LDS_BYTES) != hipSuccess) { fprintf(stderr, "kernel_launch: hipFuncSetAttribute failed\n"); grid = -1; return; }
        if (hipOccupancyMaxActiveBlocksPerMultiprocessor(&per_cu, (const void*)hybrid_fwd, NWAVES * 64, LDS_BYTES) != hipSuccess || per_cu < 1) { fprintf(stderr, "kernel_launch: occupancy query failed (%d)\n", per_cu); grid = -1; return; }
        grid = cus * per_cu;
        fprintf(stderr, "kernel_launch: %d CUs x %d blocks/CU -> grid %d\n", cus, per_cu, grid);
    }
    if (grid < 0) return;
    Args a{};
    for (int i = 0; i < 16; ++i) a.in[i] = (const float*)d_in[i];
    a.out = (float*)d_out; a.ws = (unsigned char*)d_ws;
#if MK_N_LAUNCHES == 1
    if (hipMemsetAsync((char*)d_ws + WS_BAR, 0, XCD_BAR_WORDS * 4, stream) != hipSuccess) { fprintf(stderr, "kernel_launch: hipMemsetAsync failed\n"); return; }
    a.ph_lo = 0; a.ph_hi = NPHASE;
    void* kargs[] = {&a};
    hipError_t e = hipLaunchCooperativeKernel((const void*)hybrid_fwd, dim3(grid), dim3(NWAVES * 64), kargs, LDS_BYTES, stream);
    if (e != hipSuccess) fprintf(stderr, "kernel_launch: cooperative launch failed: %s (grid %d)\n", hipGetErrorString(e), grid);
#else
    for (int p = 0; p < NPHASE; ++p) { a.ph_lo = p; a.ph_hi = p + 1; hipLaunchKernelGGL(hybrid_fwd, dim3(grid), dim3(NWAVES * 64), LDS_BYTES, stream, a); }
#endif
}
```

```cpp
#include <hip/hip_runtime.h>
#include <hip/hip_cooperative_groups.h>
#include <cstdio>
#include <cstdint>
namespace cg = cooperative_groups;
namespace pg8 {
#define PG8_LAS __attribute__((address_space(3)))
typedef unsigned short bf16_t;
typedef short bf16x8 __attribute__((ext_vector_type(8)));
typedef float f32x4 __attribute__((ext_vector_type(4)));
typedef unsigned u32x4 __attribute__((ext_vector_type(4)));
constexpr int BM = 256, BK = 64, HALF = 128, HTB = HALF * BK * 2  , STAGE_BYTES = 8 * HTB, NXCD = 8, WGM = 8;
__host__ __device__ __forceinline__ int lds_byte(int r, int c) { const int st = (r >> 4) * 2 + (c >> 5), rr = r & 15, cc = c & 31, ob = rr * 64 + cc * 2; return st * 1024 + (ob ^ (((ob >> 9) & 1) << 5)); }
__host__ __device__ __forceinline__ void stage_rc(int b, int& R, int& C) { const int st = b / 1024, sb = b % 1024, swz = sb ^ (((sb >> 9) & 1) << 5); R = (st >> 1) * 16 + swz / 64; C = (st & 1) * 32 + (swz % 64) / 2; }
__host__ __device__ __forceinline__ int perm32(int rho) { const int n = rho >> 4, i = rho & 15; return 8 * (i >> 2) + 4 * n + (i & 3); }
struct Unit { int pm, pn, sel; };
struct Gemm { const bf16_t* A; const bf16_t* Bt; int M, N, K; const bf16_t* A2; const bf16_t* Bt2; };
struct StaticOrder {
    int nM, nN, nwg, G, c;
    __host__ __device__ void init(int M, int N, int G_, int c_) { nM = M / BM; nN = N / BM; nwg = nM * nN; G = G_; c = c_; }
    __host__ __device__ bool next(int i, Unit& u) const {
        const long L = (long)i * G + c; if (L >= nwg) return false;
        int wgid = (int)L; { const int q = nwg / NXCD, r = nwg % NXCD, xcd = wgid % NXCD, off = wgid / NXCD; wgid = (xcd < r ? xcd * (q + 1) : r * (q + 1) + (xcd - r) * q) + off; }
        const int nig = WGM * nN, gid = wgid / nig, fm = gid * WGM, gsz = (nM - fm) < WGM ? (nM - fm) : WGM;
        u.pm = fm + ((wgid % nig) % gsz); u.pn = (wgid % nig) / gsz; u.sel = 0; return true;
    }
    __device__ __forceinline__ void a_ready(const Unit&) const {}
    __device__ __forceinline__ void done(const Unit&) const {}
};

typedef _Float16 h16x2n __attribute__((ext_vector_type(2)));
typedef _Float16 h16x8 __attribute__((ext_vector_type(8)));
typedef float f32x2n __attribute__((ext_vector_type(2)));
__device__ __forceinline__ unsigned cvt_pk_bf16(float lo, float hi) { const f32x2n v = {lo, hi}; return __builtin_bit_cast(unsigned, __builtin_convertvector(v, h16x2n)); }
typedef __bf16 rbf16x2n __attribute__((ext_vector_type(2)));
__device__ __forceinline__ unsigned cvt_pk_rbf16(float lo, float hi) { const f32x2n v = {lo, hi}; return __builtin_bit_cast(unsigned, __builtin_convertvector(v, rbf16x2n)); }
__device__ __forceinline__ f32x4 mfma_bf(const bf16x8 a, const bf16x8 b, const f32x4 c) { return __builtin_amdgcn_mfma_f32_16x16x32_bf16(a, b, c, 0, 0, 0); }
__device__ __forceinline__ f32x4 mfma16(const bf16x8 a, const bf16x8 b, const f32x4 c) { return __builtin_amdgcn_mfma_f32_16x16x32_f16(__builtin_bit_cast(h16x8, a), __builtin_bit_cast(h16x8, b), c, 0, 0, 0); }
typedef unsigned u32x2 __attribute__((ext_vector_type(2)));
__device__ __forceinline__ float fsigmoid(float x) { return __builtin_amdgcn_rcpf(1.0f + __builtin_amdgcn_exp2f(-1.4426950408889634f * x)); }
__device__ __forceinline__ float bf_lo(unsigned w) { return (float)__builtin_bit_cast(h16x2n, w)[0]; }
__device__ __forceinline__ float bf_hi(unsigned w) { return (float)__builtin_bit_cast(h16x2n, w)[1]; }
__device__ __forceinline__ u32x4 pack8(const f32x4 a, const f32x4 b) { u32x4 w; w.x = cvt_pk_bf16(a[0], a[1]); w.y = cvt_pk_bf16(a[2], a[3]); w.z = cvt_pk_bf16(b[0], b[1]); w.w = cvt_pk_bf16(b[2], b[3]); return w; }
__device__ __forceinline__ void unpack8(const u32x4 w, f32x4& a, f32x4& b) { a = (f32x4){bf_lo(w.x), bf_hi(w.x), bf_lo(w.y), bf_hi(w.y)}; b = (f32x4){bf_lo(w.z), bf_hi(w.z), bf_lo(w.w), bf_hi(w.w)}; }

struct EpiIn {
    static constexpr bool PERM = false, AFTER_DRAIN = false;
    bf16_t *U, *GA, *Q, *Kb, *V, *SBZ; const float *qg, *kg; bf16_t *SGA, *SGB;
    __device__ __forceinline__ void operator()(const f32x4 (&acc)[2][2][4][2], const Unit& u, int wr, int wc, int fr, int fq) const {
        const int row0 = u.pm * BM + wr * 64 + fr;
        if (u.pn < 16) {
            const int ch0 = u.pn * 64 + wc * 16 + fq * 4;
#pragma unroll
            for (int ai = 0; ai < 2; ++ai)
#pragma unroll
                for (int m = 0; m < 4; ++m) { const size_t off = (size_t)(row0 + ai * HALF + m * 16) * 1024 + ch0;
                    const f32x4 ab = acc[ai][0][m][0], ac = acc[ai][0][m][1], ax = acc[ai][1][m][0], az = acc[ai][1][m][1];
                    f32x4 uu = ac * ax, ga;
#pragma unroll
                    for (int j = 0; j < 4; ++j) ga[j] = ab[j] * az[j] * fsigmoid(az[j]);
                    u32x2 wu, wg; wu.x = cvt_pk_bf16(uu[0], uu[1]); wu.y = cvt_pk_bf16(uu[2], uu[3]); wg.x = cvt_pk_bf16(ga[0], ga[1]); wg.y = cvt_pk_bf16(ga[2], ga[3]);
                    *(u32x2*)(U + off) = wu; *(u32x2*)(GA + off) = wg; }
        } else if (u.pn < 24) {
            const bool isq = u.pn < 20; bf16_t* dst = isq ? Q : Kb; const float* g = (isq ? qg : kg) + 8 * fq; const float mul = isq ? 0.125f * 1.4426950408889634f : 1.0f;
            const int col0 = ((u.pn - 16) & 3) * 256 + wc * 64 + fq * 8;
            f32x4 gv[2][2];
#pragma unroll
            for (int bj = 0; bj < 2; ++bj)
#pragma unroll
                for (int n = 0; n < 2; ++n) gv[bj][n] = *(const f32x4*)(g + 32 * bj + 4 * n) * mul;
#pragma unroll
            for (int ai = 0; ai < 2; ++ai)
#pragma unroll
                for (int m = 0; m < 4; ++m) { float ss = 0.f;
#pragma unroll
                    for (int bj = 0; bj < 2; ++bj)
#pragma unroll
                        for (int n = 0; n < 2; ++n) { const f32x4 x = acc[ai][bj][m][n]; ss += (x[0] * x[0] + x[1] * x[1]) + (x[2] * x[2] + x[3] * x[3]); }
                    ss += __shfl_xor(ss, 16); ss += __shfl_xor(ss, 32);
                    const float rinv = __builtin_amdgcn_rsqf(ss * (1.0f / 64.0f) + 1e-6f);
                    bf16_t* rowp = dst + (size_t)(row0 + ai * HALF + m * 16) * 1024 + col0;
#pragma unroll
                    for (int bj = 0; bj < 2; ++bj) *(u32x4*)(rowp + 32 * bj) = pack8(acc[ai][bj][m][0] * rinv * gv[bj][0], acc[ai][bj][m][1] * rinv * gv[bj][1]); }
        } else if (u.pn < 32) {
            const bool isv = u.pn < 28; bf16_t* dst = isv ? V : SBZ; const int col0 = ((u.pn - 24) & 3) * 256 + wc * 64 + fq * 8;
#pragma unroll
            for (int ai = 0; ai < 2; ++ai)
#pragma unroll
                for (int m = 0; m < 4; ++m) { bf16_t* rowp = dst + (size_t)(row0 + ai * HALF + m * 16) * 1024 + col0;
#pragma unroll
                    for (int bj = 0; bj < 2; ++bj) { f32x4 v0 = acc[ai][bj][m][0], v1 = acc[ai][bj][m][1];
                        if (!isv) {
#pragma unroll
                            for (int j = 0; j < 4; ++j) { v0[j] = v0[j] * fsigmoid(v0[j]); v1[j] = v1[j] * fsigmoid(v1[j]); } }
                        *(u32x4*)(rowp + 32 * bj) = pack8(v0, v1); } }
        } else {
            unsigned char* dst = (unsigned char*)(u.pn < 40 ? SGA : SGB) + (u.pn & 7) * 256 + wc * 64 + fq * 16;
#pragma unroll
            for (int ai = 0; ai < 2; ++ai)
#pragma unroll
                for (int m = 0; m < 4; ++m) { u32x4 w;
#pragma unroll
                    for (int bj = 0; bj < 2; ++bj)
#pragma unroll
                        for (int n = 0; n < 2; ++n) { const f32x4 v = acc[ai][bj][m][n]; unsigned q = 0;
#pragma unroll
                            for (int j = 0; j < 4; ++j) q |= (unsigned)(fsigmoid(v[j]) * 255.0f + 0.5f) << (8 * j);
                            w[2 * bj + n] = q; }
                    *(u32x4*)(dst + (size_t)(row0 + ai * HALF + m * 16) * 2048) = w; }
        }
    }
};
struct EpiGate {
    static constexpr bool PERM = false, AFTER_DRAIN = false;
    bf16_t *SGA, *SGB;
    __device__ __forceinline__ void operator()(const f32x4 (&acc)[2][2][4][2], const Unit& u, int wr, int wc, int fr, int fq) const {
        const int row0 = u.pm * BM + wr * 64 + fr; bf16_t* dst = (u.pn < 8 ? SGA : SGB) + (u.pn & 7) * 256 + wc * 64 + fq * 8;
#pragma unroll
        for (int ai = 0; ai < 2; ++ai)
#pragma unroll
            for (int m = 0; m < 4; ++m) { bf16_t* rowp = dst + (size_t)(row0 + ai * HALF + m * 16) * 2048;
#pragma unroll
                for (int bj = 0; bj < 2; ++bj) { f32x4 v0 = acc[ai][bj][m][0], v1 = acc[ai][bj][m][1];
#pragma unroll
                    for (int j = 0; j < 4; ++j) { v0[j] = fsigmoid(v0[j]); v1[j] = fsigmoid(v1[j]); }
                    *(u32x4*)(rowp + 32 * bj) = pack8(v0, v1); } }
    }
};
template <int PASS> struct EpiMerge {
    static constexpr bool PERM = false, AFTER_DRAIN = false;
    bf16_t* Mb; const unsigned char* G8;
    __device__ __forceinline__ void operator()(const f32x4 (&acc)[2][2][4][2], const Unit& u, int wr, int wc, int fr, int fq) const {
        const int row0 = u.pm * BM + wr * 64 + fr;
        bf16_t* mb = Mb + (size_t)row0 * 2048 + (size_t)u.pn * 256 + wc * 64 + fq * 8;
        const unsigned char* __restrict__ g8 = G8 + (size_t)row0 * 2048 + (size_t)u.pn * 256 + wc * 64 + fq * 16;
        u32x4 cg, ng, cm[2], nm[2];
        cg = *(const u32x4*)g8;
        if (PASS == 1) {
#pragma unroll
            for (int bj = 0; bj < 2; ++bj) cm[bj] = *(const u32x4*)(mb + 32 * bj); }
#pragma unroll
        for (int g = 0; g < 8; ++g) { const int ai = g >> 2, m = g & 3; const size_t off = (size_t)(ai * HALF + m * 16) * 2048;
            if (g < 7) { const int ai2 = (g + 1) >> 2, m2 = (g + 1) & 3; const size_t off2 = (size_t)(ai2 * HALF + m2 * 16) * 2048;
                ng = *(const u32x4*)(g8 + off2);
                if (PASS == 1) {
#pragma unroll
                    for (int bj = 0; bj < 2; ++bj) nm[bj] = *(const u32x4*)(mb + off2 + 32 * bj); } }
#pragma unroll
            for (int bj = 0; bj < 2; ++bj) { f32x4 gq[2];
#pragma unroll
                for (int n = 0; n < 2; ++n) { const unsigned q = cg[2 * bj + n];
#pragma unroll
                    for (int j = 0; j < 4; ++j) gq[n][j] = (float)((q >> (8 * j)) & 255u) * (PASS == 0 ? 4.0f / 255.0f : 1.0f / 255.0f); }
                f32x4 a, b;
                if (PASS == 0) { a = gq[0] * acc[ai][bj][m][0]; b = gq[1] * acc[ai][bj][m][1]; }
                else { unpack8(cm[bj], a, b); a = a + gq[0] * acc[ai][bj][m][0]; b = b + gq[1] * acc[ai][bj][m][1]; }
                *(u32x4*)(mb + off + 32 * bj) = pack8(a, b); }
            cg = ng;
            if (PASS == 1) {
#pragma unroll
                for (int bj = 0; bj < 2; ++bj) cm[bj] = nm[bj]; } }
    }
};
struct PairOrder : StaticOrder { __device__ __forceinline__ bool next(int i, Unit& u) const { const bool r = StaticOrder::next(i >> 1, u); u.sel = i & 1; return r; } };
struct EpiMerge2 {
    static constexpr bool PERM = false, AFTER_DRAIN = false;
    bf16_t* Mb; const unsigned char* G8A; const unsigned char* G8B;
    __device__ __forceinline__ void operator()(const f32x4 (&acc)[2][2][4][2], const Unit& u, int wr, int wc, int fr, int fq) const {
        if (u.sel == 0) { const EpiMerge<0> e{Mb, G8A}; e(acc, u, wr, wc, fr, fq); } else { const EpiMerge<1> e{Mb, G8B}; e(acc, u, wr, wc, fr, fq); }
    }
};
struct EpiOut {
    static constexpr bool PERM = false, AFTER_DRAIN = false;
    const float *xp, *xs, *gate; float* out;
    __device__ __forceinline__ void operator()(const f32x4 (&acc)[2][2][4][2], const Unit& u, int wr, int wc, int fr, int fq) const {
        const int row0 = u.pm * BM + wr * 64 + fr, col0 = u.pn * 256 + wc * 64 + fq * 4; const int b = u.pm < 64 ? (u.pm >> 4) : 4;
        const float* __restrict__ xr = (u.pm < 64 ? xp : xs - (size_t)16384 * 2048) + (size_t)row0 * 2048 + col0;
        float* __restrict__ op = out + (size_t)row0 * 2048 + col0;
        f32x4 gv[2][2];
#pragma unroll
        for (int bj = 0; bj < 2; ++bj)
#pragma unroll
            for (int n = 0; n < 2; ++n) gv[bj][n] = *(const f32x4*)(gate + b * 2048 + col0 + 32 * bj + 16 * n);
        f32x4 cx[4], nx[4];
#pragma unroll
        for (int q = 0; q < 4; ++q) cx[q] = *(const f32x4*)(xr + 16 * q);
#pragma unroll
        for (int g = 0; g < 8; ++g) { const int ai = g >> 2, m = g & 3; const size_t off = (size_t)(ai * HALF + m * 16) * 2048;
            if (g < 7) { const int ai2 = (g + 1) >> 2, m2 = (g + 1) & 3; const size_t off2 = (size_t)(ai2 * HALF + m2 * 16) * 2048;
#pragma unroll
                for (int q = 0; q < 4; ++q) nx[q] = *(const f32x4*)(xr + off2 + 16 * q); }
#pragma unroll
            for (int q = 0; q < 4; ++q) { const int bj = q >> 1, n = q & 1; *(f32x4*)(op + off + 16 * q) = cx[q] + gv[bj][n] * acc[ai][bj][m][n]; }
#pragma unroll
            for (int q = 0; q < 4; ++q) cx[q] = nx[q]; }
    }
};
template <class Epi, class Sched, bool ALIGN_EPI = false, bool SP2 = false, bool BFOPS = false>
__device__ __forceinline__ void gemm_phase(PG8_LAS unsigned char* lds, const Gemm g, const Sched& S, const Epi& E) {
    const int tid = threadIdx.x, wid = __builtin_amdgcn_readfirstlane(tid >> 6), lane = tid & 63, wr = wid >> 2, wc = wid & 3, fr = lane & 15, fq = lane >> 4;
    const int K = g.K, nt = K / BK;
    unsigned voffA[2], voffB[2];
#pragma unroll
    for (int i = 0; i < 2; ++i) { int R, C; stage_rc(tid * 16 + i * 8192, R, C); const int Rb = Epi::PERM ? ((R & ~31) + perm32(R & 31)) : R;
        voffA[i] = (unsigned)(R * K + C) * 2u; voffB[i] = (unsigned)(Rb * K + C) * 2u; }
    const size_t kstep = (size_t)(BK * 2);
    const size_t hstep = (size_t)HALF * K * 2;
    const size_t tstep = 2 * hstep;
    const unsigned ldsw = (unsigned)wid * 1024u;
    const int aoff = lds_byte(wr * 64 + fr, fq * 8), boff = lds_byte(wc * 32 + fr, fq * 8);
#define PG8_SA(b, h) (((b) * 2 + (h)) * HTB)
#define PG8_SB(b, h) ((4 + (b) * 2 + (h)) * HTB)
#define PG8_STAGE(bufoff, gbase, voff) do { _Pragma("unroll") for (int _i = 0; _i < 2; ++_i) \
        __builtin_amdgcn_global_load_lds((const unsigned*)((const char*)(gbase) + (voff)[_i]), (PG8_LAS unsigned*)(lds + (bufoff) + ldsw + _i * 8192), 16, 0, 0); } while (0)
#define PG8_LDA(dst, b, h) do { _Pragma("unroll") for (int m = 0; m < 4; ++m) _Pragma("unroll") for (int k = 0; k < 2; ++k) dst[m][k] = *(const PG8_LAS bf16x8*)(lds + PG8_SA(b, h) + aoff + m * 2048 + k * 1024); } while (0)
#define PG8_LDB(dst, b, h) do { _Pragma("unroll") for (int n = 0; n < 2; ++n) _Pragma("unroll") for (int k = 0; k < 2; ++k) dst[n][k] = *(const PG8_LAS bf16x8*)(lds + PG8_SB(b, h) + boff + n * 2048 + k * 1024); } while (0)
#define PG8_MMA(ai, bj, At, Bt) do { __builtin_amdgcn_s_setprio(1); _Pragma("unroll") for (int m = 0; m < 4; ++m) _Pragma("unroll") for (int n = 0; n < 2; ++n) _Pragma("unroll") for (int k = 0; k < 2; ++k) \
        acc[ai][bj][m][n] = BFOPS ? mfma_bf(Bt[n][k], At[m][k], acc[ai][bj][m][n]) : mfma16(Bt[n][k], At[m][k], acc[ai][bj][m][n]); __builtin_amdgcn_s_setprio(0); } while (0)
#define PG8_WAIT_V(n) asm volatile("s_waitcnt vmcnt(" #n ")" ::: "memory")
#define PG8_WAIT_L(n) asm volatile("s_waitcnt lgkmcnt(" #n ")" ::: "memory")
#define PG8_BAR __builtin_amdgcn_s_barrier()
#define PG8_SCHED __builtin_amdgcn_sched_barrier(0)
    Unit cur, nxt; int ui = 0;
    if (!S.next(0, cur)) return;
    f32x4 acc[2][2][4][2];
#pragma unroll
    for (int a = 0; a < 2; ++a)
#pragma unroll
        for (int b = 0; b < 2; ++b)
#pragma unroll
            for (int m = 0; m < 4; ++m)
#pragma unroll
                for (int n = 0; n < 2; ++n) acc[a][b][m][n] = (f32x4){0.f, 0.f, 0.f, 0.f};
    bf16x8 At[4][2], B0[2][2], B1[2][2];
    const char* cA = (const char*)(cur.sel ? g.A2 : g.A) + (size_t)cur.pm * tstep; const char* cB = (const char*)(cur.sel ? g.Bt2 : g.Bt) + (size_t)cur.pn * tstep;
    S.a_ready(cur);
    if constexpr (SP2) {
        PG8_STAGE(PG8_SB(0, 0), cB, voffB); PG8_STAGE(PG8_SB(0, 1), cB + hstep, voffB); PG8_STAGE(PG8_SA(0, 0), cA, voffA); PG8_STAGE(PG8_SA(0, 1), cA + hstep, voffA);
        if (wr == 1) PG8_BAR;
        PG8_WAIT_V(2); PG8_BAR;
        PG8_STAGE(PG8_SB(1, 0), cB + kstep, voffB); PG8_STAGE(PG8_SA(1, 0), cA + kstep, voffA); PG8_STAGE(PG8_SB(1, 1), cB + hstep + kstep, voffB);
        PG8_WAIT_V(6); PG8_BAR;
    } else {
        PG8_STAGE(PG8_SB(0, 0), cB, voffB); PG8_STAGE(PG8_SA(0, 0), cA, voffA); PG8_STAGE(PG8_SB(0, 1), cB + hstep, voffB); PG8_STAGE(PG8_SA(0, 1), cA + hstep, voffA);
        if (wr == 1) PG8_BAR;
        PG8_WAIT_V(4); PG8_BAR;
        PG8_STAGE(PG8_SB(1, 0), cB + kstep, voffB); PG8_STAGE(PG8_SA(1, 0), cA + kstep, voffA); PG8_STAGE(PG8_SB(1, 1), cB + hstep + kstep, voffB);
        PG8_WAIT_V(6); PG8_BAR;
    }
    for (;;) {
        const bool has_next = S.next(ui + 1, nxt);
        const char* nA = has_next ? (const char*)(nxt.sel ? g.A2 : g.A) + (size_t)nxt.pm * tstep : cA; const char* nB = has_next ? (const char*)(nxt.sel ? g.Bt2 : g.Bt) + (size_t)nxt.pn * tstep : cB;
        for (int t = 0; t < nt; t += 2) {
            const bool last = (t == nt - 2);
            const char* a1 = cA + (size_t)(t + 1) * kstep;
            const char* a2 = last ? nA : cA + (size_t)(t + 2) * kstep; const char* b2 = last ? nB : cB + (size_t)(t + 2) * kstep;
            const char* a3 = a2 + kstep; const char* b3 = b2 + kstep;
            if (last && has_next) S.a_ready(nxt);
            if constexpr (SP2) {
            PG8_LDB(B0, 0, 0); PG8_LDB(B1, 0, 1); PG8_SCHED; PG8_LDA(At, 0, 0); PG8_STAGE(PG8_SA(1, 1), a1 + hstep, voffA);
            PG8_WAIT_V(8); PG8_WAIT_L(0); PG8_BAR; PG8_MMA(0, 0, At, B0); PG8_MMA(0, 1, At, B1); PG8_BAR; PG8_SCHED;
            PG8_LDA(At, 0, 1); PG8_STAGE(PG8_SB(0, 0), b2, voffB); PG8_STAGE(PG8_SB(0, 1), b2 + hstep, voffB); PG8_STAGE(PG8_SA(0, 0), a2, voffA);
            PG8_WAIT_V(8); PG8_WAIT_L(0); PG8_BAR; PG8_MMA(1, 0, At, B0); PG8_MMA(1, 1, At, B1); PG8_BAR; PG8_SCHED;
            PG8_LDB(B0, 1, 0); PG8_LDB(B1, 1, 1); PG8_SCHED; PG8_LDA(At, 1, 0); PG8_STAGE(PG8_SA(0, 1), a2 + hstep, voffA);
            PG8_WAIT_V(8); PG8_WAIT_L(0); PG8_BAR; PG8_MMA(0, 0, At, B0); PG8_MMA(0, 1, At, B1); PG8_BAR; PG8_SCHED;
            PG8_LDA(At, 1, 1); PG8_STAGE(PG8_SB(1, 0), b3, voffB); PG8_STAGE(PG8_SB(1, 1), b3 + hstep, voffB); PG8_STAGE(PG8_SA(1, 0), a3, voffA);
            PG8_WAIT_V(8); PG8_WAIT_L(0); PG8_BAR; PG8_MMA(1, 0, At, B0); PG8_MMA(1, 1, At, B1); PG8_BAR; PG8_SCHED;
            } else {
            PG8_LDB(B0, 0, 0); PG8_SCHED; PG8_LDA(At, 0, 0); PG8_STAGE(PG8_SA(1, 1), a1 + hstep, voffA);
            PG8_WAIT_L(8); PG8_BAR; PG8_WAIT_L(0); PG8_MMA(0, 0, At, B0); PG8_BAR; PG8_SCHED;
            PG8_LDB(B1, 0, 1); PG8_STAGE(PG8_SB(0, 0), b2, voffB);
            PG8_BAR; PG8_WAIT_L(0); PG8_MMA(0, 1, At, B1); PG8_BAR;
            PG8_LDA(At, 0, 1); PG8_STAGE(PG8_SA(0, 0), a2, voffA);
            PG8_BAR; PG8_WAIT_L(0); PG8_MMA(1, 0, At, B0); PG8_BAR; PG8_SCHED;
            PG8_STAGE(PG8_SB(0, 1), b2 + hstep, voffB);
            PG8_WAIT_V(6); PG8_BAR; PG8_MMA(1, 1, At, B1); PG8_BAR;
            PG8_LDB(B0, 1, 0); PG8_SCHED; PG8_LDA(At, 1, 0); PG8_STAGE(PG8_SA(0, 1), a2 + hstep, voffA);
            PG8_WAIT_L(8); PG8_BAR; PG8_WAIT_L(0); PG8_MMA(0, 0, At, B0); PG8_BAR; PG8_SCHED;
            PG8_LDB(B1, 1, 1); PG8_STAGE(PG8_SB(1, 0), b3, voffB);
            PG8_BAR; PG8_WAIT_L(0); PG8_MMA(0, 1, At, B1); PG8_BAR;
            PG8_LDA(At, 1, 1); PG8_STAGE(PG8_SA(1, 0), a3, voffA);
            PG8_BAR; PG8_WAIT_L(0); PG8_MMA(1, 0, At, B0); PG8_BAR; PG8_SCHED;
            PG8_STAGE(PG8_SB(1, 1), b3 + hstep, voffB);
            PG8_WAIT_V(6); PG8_BAR; PG8_MMA(1, 1, At, B1); PG8_BAR;
            }
        }
        if constexpr (ALIGN_EPI) { if (wr == 0) PG8_BAR; }
        if constexpr (!Epi::AFTER_DRAIN) { E(acc, cur, wr, wc, fr, fq); S.done(cur); }
        if (!has_next) break;
#pragma unroll
        for (int a = 0; a < 2; ++a)
#pragma unroll
            for (int b = 0; b < 2; ++b)
#pragma unroll
                for (int m = 0; m < 4; ++m)
#pragma unroll
                    for (int n = 0; n < 2; ++n) acc[a][b][m][n] = (f32x4){0.f, 0.f, 0.f, 0.f};
        cur = nxt; cA = nA; cB = nB; ++ui;
        if constexpr (ALIGN_EPI) { if (wr == 1) PG8_BAR; }
    }
    PG8_WAIT_V(0);
    if constexpr (!ALIGN_EPI) { if (wr == 0) PG8_BAR; }
    PG8_BAR;
    if constexpr (Epi::AFTER_DRAIN) { E.fused(acc, cur, wr, wc, fr, fq, lds, wid, lane); S.done(cur); }
#undef PG8_SA
#undef PG8_SB
#undef PG8_STAGE
#undef PG8_LDA
#undef PG8_LDB
#undef PG8_MMA
#undef PG8_WAIT_V
#undef PG8_WAIT_L
#undef PG8_BAR
#undef PG8_SCHED
}
}
constexpr int NWAVES = 8;
constexpr int D = 2048, NTOK = 32768, NPROMPT = 16384, SEQP = 4096, DB = 1024, DIN = 12288;
constexpr size_t MiB = 1u << 20;
constexpr size_t WS_MODP = 0, WS_GATE = 1 * MiB, WS_BAR = 1280 * 1024;
constexpr size_t WS_WIN = 2 * MiB, WS_WPA = 50 * MiB, WS_WPB = 54 * MiB, WS_WO = 58 * MiB;
constexpr size_t WS_GA = 66 * MiB, WS_Q = 130 * MiB, WS_K = 194 * MiB, WS_V = 258 * MiB, WS_SBZ = 322 * MiB, WS_U = 386 * MiB, WS_END = 578 * MiB;
constexpr size_t WS_SGA = 450 * MiB, OUT_G8A = 128 * MiB, OUT_G8B = 192 * MiB;
constexpr int RING_BYTES = 131072, BIAS_OFF = 131072, LDS_BYTES = 131072 + 8192;
typedef unsigned short bf16;
typedef unsigned v4u __attribute__((ext_vector_type(4)));
typedef unsigned v2u __attribute__((ext_vector_type(2)));
typedef float f32x4 __attribute__((ext_vector_type(4)));
typedef short bf16x8 __attribute__((ext_vector_type(8)));
typedef short s16x4 __attribute__((ext_vector_type(4)));
#define LAS __attribute__((address_space(3)))
__device__ __forceinline__ unsigned f2bf(float f) { unsigned u = __builtin_bit_cast(unsigned, f); return (u + 0x7fffu + ((u >> 16) & 1u)) >> 16; }
__device__ __forceinline__ unsigned pk2(float lo, float hi) { return pg8::cvt_pk_bf16(lo, hi); }
__device__ __forceinline__ float wave_sum(float v) {
#pragma unroll
    for (int o = 1; o < 64; o <<= 1) v += __shfl_xor(v, o);
    return v;
}
struct Args { const float* in[16]; float* out; unsigned char* ws; int ph_lo, ph_hi; };

template <int MODE> __device__ __forceinline__ int dest_row(int s) {
    if (MODE == 1 && s < 4096) { const int kind = s >> 10, ch = s & 1023, tile = ch >> 6, chl = ch & 63; return tile * 256 + 128 * (kind >> 1) + 32 * (chl >> 4) + 16 * (kind & 1) + (chl & 15); }
    const int cl = s & 255;
    if (MODE == 2) return (s & ~255) + 128 * ((cl >> 5) & 1) + 32 * (cl >> 6) + 16 * ((cl >> 4) & 1) + 4 * ((cl >> 2) & 3) + (cl & 3);
    return (s & ~255) + 128 * ((cl >> 5) & 1) + 32 * (cl >> 6) + 16 * ((cl >> 2) & 1) + 4 * ((cl >> 3) & 3) + (cl & 3);
}
template <int MODE> __device__ __forceinline__ void p0_transpose_item(const float* W, int K, int N, bf16* WT, LAS float* scr, int item, int lane) {
    const int nblk = N / 32, kb = item / nblk, nb = item % nblk, k0 = 64 * kb, n0 = 32 * nb;
#pragma unroll 8
    for (int i = 0; i < 32; ++i) { const int kk = 2 * i + (lane >> 5); scr[kk * 33 + (lane & 31)] = W[(size_t)(k0 + kk) * N + n0 + (lane & 31)]; }
    asm volatile("s_waitcnt lgkmcnt(0)" ::: "memory");
    const int c = lane & 7;
#pragma unroll
    for (int j = 0; j < 4; ++j) { const int n = (lane >> 3) + 8 * j; const LAS float* s = scr + (8 * c) * 33 + n;
        v4u o;
        if (MODE == 1) { o.x = pg8::cvt_pk_rbf16(s[0 * 33], s[1 * 33]); o.y = pg8::cvt_pk_rbf16(s[2 * 33], s[3 * 33]); o.z = pg8::cvt_pk_rbf16(s[4 * 33], s[5 * 33]); o.w = pg8::cvt_pk_rbf16(s[6 * 33], s[7 * 33]); }
        else { o.x = pk2(s[0 * 33], s[1 * 33]); o.y = pk2(s[2 * 33], s[3 * 33]); o.z = pk2(s[4 * 33], s[5 * 33]); o.w = pk2(s[6 * 33], s[7 * 33]); }
        *(v4u*)(WT + (size_t)dest_row<MODE>(n0 + n) * K + k0 + 8 * c) = o; }
    asm volatile("s_waitcnt lgkmcnt(0)" ::: "memory");
}
__device__ __forceinline__ void p0_item(const Args& a, LAS float* scr, int it, int lane) {
    unsigned char* ws = a.ws;
    constexpr int I_IN = (D / 64) * (DIN / 32), I_P = (DB / 64) * (D / 32), I_O = (D / 64) * (D / 32);
    if (it < I_IN) { p0_transpose_item<1>(a.in[7], D, DIN, (bf16*)(ws + WS_WIN), scr, it, lane); return; } it -= I_IN;
    if (it < I_P) { p0_transpose_item<0>(a.in[13], DB, D, (bf16*)(ws + WS_WPA), scr, it, lane); return; } it -= I_P;
    if (it < I_P) { p0_transpose_item<0>(a.in[14], DB, D, (bf16*)(ws + WS_WPB), scr, it, lane); return; } it -= I_P;
    if (it < I_O) p0_transpose_item<2>(a.in[15], D, D, (bf16*)(ws + WS_WO), scr, it, lane);
}
__device__ __forceinline__ void p0_phase(const Args& a, LAS unsigned char* lds, int tid, int lane, int wave, int G) {
    const float* cp = a.in[2]; const float* csm = a.in[3]; const float* wada = a.in[5];
    float* modp = (float*)(a.ws + WS_MODP);
    LAS float* sc = (LAS float*)lds; LAS float* red = (LAS float*)(lds + 8192);
    for (int task = blockIdx.x; task < 192; task += G) {
        const int cgi = task % 24, ks = task / 24;
        for (int e = tid; e < 1280; e += 512) { const int b = e >> 8, kk = e & 255; const float cv = b < 4 ? cp[b * D + ks * 256 + kk] : csm[ks * 256 + kk]; sc[e] = cv * pg8::fsigmoid(cv); }
        __syncthreads();
        const int k0 = ks * 256 + wave * 32, n = cgi * 256 + lane * 4;
        f32x4 ac[5];
#pragma unroll
        for (int b = 0; b < 5; ++b) ac[b] = (f32x4){0.f, 0.f, 0.f, 0.f};
#pragma unroll 8
        for (int kk = 0; kk < 32; ++kk) { const f32x4 wv = *(const f32x4*)(wada + (size_t)(k0 + kk) * 6144 + n);
#pragma unroll
            for (int b = 0; b < 5; ++b) ac[b] += wv * sc[b * 256 + wave * 32 + kk]; }
#pragma unroll
        for (int b = 0; b < 5; ++b)
#pragma unroll
            for (int j = 0; j < 4; ++j) red[(wave * 20 + b * 4 + j) * 64 + lane] = ac[b][j];
        __syncthreads();
        for (int e = tid; e < 1280; e += 512) { const int q = e >> 6, l = e & 63; float s = 0.f;
#pragma unroll
            for (int w = 0; w < 8; ++w) s += red[(w * 20 + q) * 64 + l];
            modp[(size_t)(ks * 5 + (q >> 2)) * 6144 + cgi * 256 + l * 4 + (q & 3)] = s; }
        __syncthreads();
    }
}
__device__ __forceinline__ void p0_copy_phase(const Args& a, LAS unsigned char* lds, int lane, int wave, int G) {
    LAS float* scr = (LAS float*)(lds + wave * 16384);
    for (int it = blockIdx.x * NWAVES + wave; it < 16384; it += G * NWAVES) p0_item(a, scr, it, lane);
}
__device__ __forceinline__ void p1_phase(const Args& a, LAS unsigned char* lds, int tid, int lane, int wave, int G) {
    const float* modp = (const float*)(a.ws + WS_MODP); const float* bada = a.in[6]; const float* ng = a.in[4];
    float* gate = (float*)(a.ws + WS_GATE); bf16* H = (bf16*)a.out;
    LAS f32x4* mS = (LAS f32x4*)lds; LAS f32x4* mB = (LAS f32x4*)(lds + 8192);
    for (int rb = blockIdx.x; rb < NTOK / 128; rb += G) {
        const int row0 = rb * 128, b = row0 < NPROMPT ? row0 / SEQP : 4;
        __syncthreads();
        { const int k4 = tid * 4; f32x4 sh = *(const f32x4*)(bada + k4), sl = *(const f32x4*)(bada + 2048 + k4), gt = *(const f32x4*)(bada + 4096 + k4);
#pragma unroll
          for (int ks = 0; ks < 8; ++ks) { const float* mp = modp + (size_t)(ks * 5 + b) * 6144 + k4; sh += *(const f32x4*)mp; sl += *(const f32x4*)(mp + 2048); gt += *(const f32x4*)(mp + 4096); }
          mS[tid] = *(const f32x4*)(ng + k4) * (sl + 1.0f); mB[tid] = sh;
          if ((row0 & (SEQP - 1)) == 0 && (row0 <= NPROMPT)) *(f32x4*)(gate + b * 2048 + k4) = gt; }
        __syncthreads();
        for (int i = 0; i < 16; ++i) { const int row = row0 + wave * 16 + i;
            const float* xr = row < NPROMPT ? a.in[0] + (size_t)row * D : a.in[1] + (size_t)(row - NPROMPT) * D;
            f32x4 v[8]; float ss = 0.f;
#pragma unroll
            for (int j = 0; j < 8; ++j) { v[j] = *(const f32x4*)(xr + 4 * lane + 256 * j); ss += (v[j][0] * v[j][0] + v[j][1] * v[j][1]) + (v[j][2] * v[j][2] + v[j][3] * v[j][3]); }
            const float rstd = 1.0f / sqrtf(wave_sum(ss) * (1.0f / D) + 1e-6f);
            bf16* hr = H + (size_t)row * D + 4 * lane;
#pragma unroll
            for (int j = 0; j < 8; ++j) { const f32x4 o = v[j] * rstd * mS[lane + 64 * j] + mB[lane + 64 * j]; v2u w; w.x = pg8::cvt_pk_rbf16(o[0], o[1]); w.y = pg8::cvt_pk_rbf16(o[2], o[3]); *(v2u*)(hr + 256 * j) = w; } }
    }
}
__device__ __forceinline__ void conv_phase(const Args& a, int tid, int G) {
    const bf16* U = (const bf16*)(a.ws + WS_U); bf16* GA = (bf16*)(a.ws + WS_GA);
    const float* cw = a.in[8]; const float* cb = a.in[9];
    const size_t gt = (size_t)blockIdx.x * 512 + tid, nthr = (size_t)G * 512;
    const int c8 = (int)(gt & 127) * 8;
    f32x4 w0a = *(const f32x4*)(cw + c8), w0b = *(const f32x4*)(cw + c8 + 4), w1a = *(const f32x4*)(cw + 1024 + c8), w1b = *(const f32x4*)(cw + 1024 + c8 + 4);
    f32x4 w2a = *(const f32x4*)(cw + 2048 + c8), w2b = *(const f32x4*)(cw + 2048 + c8 + 4), ba = *(const f32x4*)(cb + c8), bb = *(const f32x4*)(cb + c8 + 4);
    const bf16* __restrict__ Ur = U; bf16* __restrict__ GAw = GA;
    const v4u z = (v4u){0u, 0u, 0u, 0u};
    v4u um, u0, up, g;
    { const int tok = (int)(gt >> 7); const int tl = tok < NPROMPT ? (tok & (SEQP - 1)) : tok - NPROMPT, L = tok < NPROMPT ? SEQP : NTOK - NPROMPT; const size_t off = (size_t)tok * 1024 + c8;
      um = tl > 0 ? *(const v4u*)(Ur + off - 1024) : z; u0 = *(const v4u*)(Ur + off); up = tl < L - 1 ? *(const v4u*)(Ur + off + 1024) : z; g = *(const v4u*)(GAw + off); }
    for (size_t idx = gt; idx < (size_t)NTOK * 128; idx += nthr) {
        const size_t off = (size_t)(idx >> 7) * 1024 + c8;
        v4u num = z, nu0 = z, nup = z, ng = z; const size_t nidx = idx + nthr;
        if (nidx < (size_t)NTOK * 128) { const int tok = (int)(nidx >> 7); const int tl = tok < NPROMPT ? (tok & (SEQP - 1)) : tok - NPROMPT, L = tok < NPROMPT ? SEQP : NTOK - NPROMPT; const size_t noff = (size_t)tok * 1024 + c8;
            num = tl > 0 ? *(const v4u*)(Ur + noff - 1024) : z; nu0 = *(const v4u*)(Ur + noff); nup = tl < L - 1 ? *(const v4u*)(Ur + noff + 1024) : z; ng = *(const v4u*)(GAw + noff); }
        f32x4 ma, mb, ca, cbv, pa, pb, ga, gb;
        pg8::unpack8(um, ma, mb); pg8::unpack8(u0, ca, cbv); pg8::unpack8(up, pa, pb); pg8::unpack8(g, ga, gb);
        const f32x4 ya = ga * (ma * w0a + ca * w1a + pa * w2a + ba) * 0.25f, yb = gb * (mb * w0b + cbv * w1b + pb * w2b + bb) * 0.25f;
        *(v4u*)(GAw + off) = pg8::pack8(ya, yb);
        um = num; u0 = nu0; up = nup; g = ng;
    }
}
__device__ __forceinline__ s16x4 vtr(const LAS unsigned char* p) { return __builtin_bit_cast(s16x4, __builtin_amdgcn_ds_read_tr16_b64_v4i16((LAS s16x4*)p)); }
__device__ __forceinline__ void attn_phase(const Args& a, LAS unsigned char* lds, int tid, int lane, int wave, int vcu, int G) {
    bf16* Q = (bf16*)(a.ws + WS_Q); const bf16* Kb = (const bf16*)(a.ws + WS_K); const bf16* V = (const bf16*)(a.ws + WS_V); const bf16* SBZ = (const bf16*)(a.ws + WS_SBZ);
    const float* rpb = a.in[12];
    const int fr = lane & 15, fq = lane >> 4, hh = wave >> 2, j = wave & 3;
    const int cwin0 = j == 0 ? 0 : (j == 1 ? 8 : (j == 2 ? 24 : 32));
    const int qcol = 16 * j + fr; const int cs = min(max(qcol - 8, 0), 48);
    const int kc0 = cwin0 + 4 * fq - cs;
    const int dcb = cwin0 + 4 * fq - qcol + 15 + 16;
    LAS unsigned char* vimg = lds + hh * 65536;
    LAS float* bimg = (LAS float*)(lds + BIAS_OFF) + hh * 960;
    bool sel[4]; int bofs[4];
#pragma unroll
    for (int e = 0; e < 4; ++e) { sel[e] = (kc0 + e) >= 0; bofs[e] = dcb + (sel[e] ? e : 16 + e); }
    const int vtok = tid >> 4, vc16 = tid & 15, vc = vc16 & 7;
    for (int chunk = vcu; chunk < 256; chunk += G) {
        const int hp = chunk >> 5, crow = chunk & 31;
        int tokbase, r0, R; if (crow < 16) { tokbase = (crow >> 2) * SEQP; r0 = (crow & 3) * 16; R = 64; } else { tokbase = NPROMPT; r0 = (crow - 16) * 16; R = 256; }
        const int h = 2 * hp + hh;
        const bf16* vbase = V + (size_t)tokbase * 1024 + hp * 128 + vc16 * 8;
        const int rs0 = min(max(r0 - 4, 0), R - 8);
        { v4u vt[16];
#pragma unroll
          for (int p = 0; p < 16; ++p) { const int t = vtok + 32 * p; vt[p] = *(const v4u*)(vbase + (size_t)(rs0 * 64 + t) * 1024); }
          float bv[2];
#pragma unroll
          for (int p = 0; p < 2; ++p) { const int e = tid + 512 * p; bv[p] = e < 930 ? rpb[2 * hp * 465 + e] : 0.f; }
          __syncthreads();
#pragma unroll
          for (int p = 0; p < 16; ++p) { const int t = vtok + 32 * p, tok = (((rs0 + (t >> 6)) & 7) << 6) + (t & 63);
              *(LAS v4u*)(lds + (vc16 >> 3) * 65536 + 128 * tok + 32 * ((vc >> 1) ^ ((tok >> 1) & 3)) + 16 * (vc & 1)) = vt[p]; }
#pragma unroll
          for (int p = 0; p < 2; ++p) { const int e = tid + 512 * p; if (e < 930) { const int h2 = e >= 465 ? 1 : 0, rem = e - 465 * h2, dr = rem / 31, dc = rem - 31 * dr;
              ((LAS float*)(lds + BIAS_OFF))[h2 * 960 + dr * 64 + dc + 16] = bv[p] * 1.4426950408889634f - 4.0f; } }
          __syncthreads(); }
        int qtok = tokbase + r0 * 64 + 16 * j + fr;
        bf16x8 qf0 = *(const bf16x8*)(Q + (size_t)qtok * 1024 + h * 64 + 8 * fq), qf1 = *(const bf16x8*)(Q + (size_t)qtok * 1024 + h * 64 + 8 * fq + 32);
        v2u zz[4];
#pragma unroll
        for (int n = 0; n < 4; ++n) zz[n] = *(const v2u*)(SBZ + (size_t)qtok * 1024 + h * 64 + 4 * fq + 16 * n);
#pragma unroll 1
        for (int it = 0; it < 16; ++it) {
            const int r = r0 + it, rs = min(max(r - 4, 0), R - 8);
            const int rsn = min(max(r + 1 - 4, 0), R - 8); const bool more = it < 15, newrow = more && (rsn != rs);
            v4u nv[2]; bf16x8 nq0, nq1; v2u nz[4];
            if (newrow) {
#pragma unroll
                for (int p = 0; p < 2; ++p) nv[p] = *(const v4u*)(vbase + (size_t)((rsn + 7) * 64 + vtok + 32 * p) * 1024); }
            const int qtokn = qtok + 64;
            if (more) { nq0 = *(const bf16x8*)(Q + (size_t)qtokn * 1024 + h * 64 + 8 * fq); nq1 = *(const bf16x8*)(Q + (size_t)qtokn * 1024 + h * 64 + 8 * fq + 32);
#pragma unroll
                for (int n = 0; n < 4; ++n) nz[n] = *(const v2u*)(SBZ + (size_t)qtokn * 1024 + h * 64 + 4 * fq + 16 * n); }
            const bf16* kp = Kb + (size_t)(tokbase + rs * 64 + cwin0 + fr) * 1024 + h * 64 + 8 * fq;
            float sum = 0.f; bf16x8 pf[8];
#pragma unroll
            for (int i = 0; i < 8; ++i) { f32x4 sb[2];
#pragma unroll
                for (int b = 0; b < 2; ++b) { const bf16* kq = kp + (size_t)(i * 64 + 16 * b) * 1024;
                    const bf16x8 kf0 = *(const bf16x8*)kq, kf1 = *(const bf16x8*)(kq + 32);
                    f32x4 acc = (f32x4){0.f, 0.f, 0.f, 0.f};
                    acc = pg8::mfma16(kf0, qf0, acc);
                    acc = pg8::mfma16(kf1, qf1, acc);
                    sb[b] = acc; }
                const LAS float* brow = bimg + (rs + i - r + 7) * 64; float p0[4], p1[4];
#pragma unroll
                for (int e = 0; e < 4; ++e) { const float pv = __builtin_amdgcn_exp2f((sel[e] ? sb[0][e] : sb[1][e]) + brow[bofs[e]]); sum += pv; p0[e] = sel[e] ? pv : 0.f; p1[e] = sel[e] ? 0.f : pv; }
                v4u w; w.x = pg8::cvt_pk_bf16(p0[0], p0[1]); w.y = pg8::cvt_pk_bf16(p0[2], p0[3]); w.z = pg8::cvt_pk_bf16(p1[0], p1[1]); w.w = pg8::cvt_pk_bf16(p1[2], p1[3]);
                pf[i] = __builtin_bit_cast(bf16x8, w); }
            sum += __shfl_xor(sum, 16); sum += __shfl_xor(sum, 32);
            f32x4 o[4];
#pragma unroll
            for (int n = 0; n < 4; ++n) o[n] = (f32x4){0.f, 0.f, 0.f, 0.f};
#pragma unroll
            for (int i = 0; i < 8; ++i) { const int k0 = (((rs + i) & 7) << 6) + cwin0 + 4 * fq + (fr >> 2), k1 = k0 + 16;
#pragma unroll
                for (int n = 0; n < 4; ++n) {
                    const s16x4 t0 = vtr(vimg + 128 * k0 + 32 * (n ^ ((k0 >> 1) & 3)) + 8 * (fr & 3));
                    const s16x4 t1 = vtr(vimg + 128 * k1 + 32 * (n ^ ((k1 >> 1) & 3)) + 8 * (fr & 3));
                    const bf16x8 vf = (bf16x8){t0[0], t0[1], t0[2], t0[3], t1[0], t1[1], t1[2], t1[3]};
                    o[n] = pg8::mfma16(vf, pf[i], o[n]); } }
            const float inv = 1.0f / sum;
            const size_t ob = (size_t)qtok * 1024 + h * 64 + 4 * fq;
#pragma unroll
            for (int n = 0; n < 4; ++n) { const v2u z = zz[n];
                v2u w; w.x = pg8::cvt_pk_bf16(o[n][0] * inv * pg8::bf_lo(z.x), o[n][1] * inv * pg8::bf_hi(z.x)); w.y = pg8::cvt_pk_bf16(o[n][2] * inv * pg8::bf_lo(z.y), o[n][3] * inv * pg8::bf_hi(z.y));
                *(v2u*)(Q + ob + 16 * n) = w; }
            if (newrow) {
                __syncthreads();
#pragma unroll
                for (int p = 0; p < 2; ++p) { const int tok = (((rsn + 7) & 7) << 6) + vtok + 32 * p;
                    *(LAS v4u*)(lds + (vc16 >> 3) * 65536 + 128 * tok + 32 * ((vc >> 1) ^ ((tok >> 1) & 3)) + 16 * (vc & 1)) = nv[p]; }
                __syncthreads(); }
            if (more) { qf0 = nq0; qf1 = nq1;
#pragma unroll
                for (int n = 0; n < 4; ++n) zz[n] = nz[n]; }
            qtok = qtokn;
        }
    }
}
#define XB_TMO      128
#define XB_XCNT(j)  (256  + 64 * (j))
#define XB_XSUB(j)  (1280 + 64 * (j))
#define XB_XGEN(j)  (2304 + 64 * (j))
#define XB_TOP      3328
#define XB_TOPGEN   3392
#define XCD_BAR_WORDS 3456
#define XB_SPIN_CAP (1u << 18)

__device__ __forceinline__ unsigned xb_ld(unsigned* p)              { return __hip_atomic_load(p, __ATOMIC_RELAXED, __HIP_MEMORY_SCOPE_AGENT); }
__device__ __forceinline__ unsigned xb_add(unsigned* p, unsigned v) { return __hip_atomic_fetch_add(p, v, __ATOMIC_RELAXED, __HIP_MEMORY_SCOPE_AGENT); }
__device__ __forceinline__ unsigned xb_xcc_id() { return (unsigned)__builtin_amdgcn_s_getreg((3 << 11) | 20) & 0xFu; }
#define XB_SPIN(cond, bar) do { unsigned _sp = 0; while (cond) { __builtin_amdgcn_s_sleep(1); \
    if ((++_sp & 255u) == 0u) { if (xb_ld(&(bar)[XB_TMO])) break; if (_sp > XB_SPIN_CAP) { atomicAdd(&(bar)[XB_TMO], 1u); break; } } } } while (0)

struct XcdBarrier {
    unsigned* bar; unsigned x;
    volatile LAS unsigned* st;
};

__device__ __forceinline__ XcdBarrier xcd_barrier_post(unsigned* bar, volatile LAS unsigned* st) {
    XcdBarrier b; b.bar = bar; b.x = xb_xcc_id(); b.st = st;
    if (threadIdx.x == 0) (void)xb_add(&bar[XB_XCNT(b.x)], 1u);
    return b;
}
__device__ __forceinline__ void xcd_barrier_complete(unsigned* bar, unsigned x, unsigned& nloc, unsigned& nx) {
    const unsigned G = gridDim.x * gridDim.y * gridDim.z;
    unsigned sum, cnt, mine, sp = 0u;
    for (;;) {
        sum = 0u; cnt = 0u; mine = 0u;
#pragma unroll
        for (unsigned j = 0; j < 16; ++j) { const unsigned c = xb_ld(&bar[XB_XCNT(j)]); sum += c; cnt += (c > 0u) ? 1u : 0u; mine = (j == x) ? c : mine; }
        if (sum == G) break;
        __builtin_amdgcn_s_sleep(1);
        if ((++sp & 255u) == 0u) { if (xb_ld(&bar[XB_TMO])) break; if (sp > XB_SPIN_CAP) { atomicAdd(&bar[XB_TMO], 1u); break; } }
    }
    nloc = mine > 0u ? mine : 1u; nx = cnt > 0u ? cnt : 1u;
}

__device__ __forceinline__ void xcd_barrier(const XcdBarrier& b) {
    asm volatile("s_waitcnt vmcnt(0)" ::: "memory");
    __syncthreads();
    if (threadIdx.x == 0) {
        unsigned* bar = b.bar;
        __builtin_amdgcn_s_waitcnt(0);
        unsigned nloc = b.st[0], nx = b.st[1];
        if (nloc == 0u) { xcd_barrier_complete(bar, b.x, nloc, nx); b.st[0] = nloc; b.st[1] = nx; }
        const unsigned old = xb_add(&bar[XB_XSUB(b.x)], 1u);
        const unsigned gen = old / nloc;
        if (old + 1u == (gen + 1u) * nloc) {
            __builtin_amdgcn_fence(__ATOMIC_RELEASE, "agent");
            asm volatile("s_waitcnt vmcnt(0)" ::: "memory");
            const unsigned og = xb_add(&bar[XB_TOP], 1u);
            const unsigned tg = og / nx;
            if (og + 1u == (tg + 1u) * nx) xb_add(&bar[XB_TOPGEN], 1u);
            else XB_SPIN(xb_ld(&bar[XB_TOPGEN]) == tg, bar);
            __builtin_amdgcn_fence(__ATOMIC_ACQUIRE, "agent");
            xb_add(&bar[XB_XGEN(b.x)], 1u);
            asm volatile("s_waitcnt vmcnt(0)" ::: "memory");
        } else {
            XB_SPIN(xb_ld(&bar[XB_XGEN(b.x)]) == gen, bar);
            __builtin_amdgcn_fence(__ATOMIC_ACQUIRE, "agent");
            asm volatile("s_waitcnt vmcnt(0)" ::: "memory");
        }
    }
    __syncthreads();
}

#ifndef MK_N_LAUNCHES
#define MK_N_LAUNCHES 1
#endif
constexpr int NPHASE = 6;
__global__ void __launch_bounds__(NWAVES * 64, 2) hybrid_fwd(Args args) {
    extern __shared__ __attribute__((aligned(16))) unsigned char lds_raw[];
    LAS unsigned char* lds = (LAS unsigned char*)lds_raw;
    const int tid = threadIdx.x, lane = tid & 63, wave = __builtin_amdgcn_readfirstlane(tid >> 6);
    const int G = gridDim.x, bx = blockIdx.x, vcu = (G % 8 == 0) ? (bx % 8) * (G / 8) + bx / 8 : bx;
    unsigned char* ws = args.ws;
    const int lo = args.ph_lo, hi = args.ph_hi;
#define IN(k) (lo <= (k) && (k) < hi)
#define SEAM(k) do { if (IN(k) && IN((k) + 1)) { xcd_barrier(xbar); } } while (0)
    bf16* H = (bf16*)args.out;
    volatile LAS unsigned* xst = (volatile LAS unsigned*)(lds + BIAS_OFF + 7936);
    if (tid < 2) xst[tid] = 0u;
    __syncthreads();
    const XcdBarrier xbar = xcd_barrier_post((unsigned*)(ws + WS_BAR), xst);
    if (lo < 0) cg::this_grid().sync();
    if (IN(0)) { p0_phase(args, lds, tid, lane, wave, G); }
    SEAM(0);
    if (IN(1)) { p1_phase(args, lds, tid, lane, wave, G); __syncthreads(); p0_copy_phase(args, lds, lane, wave, G); }
    SEAM(1);
    if (IN(2)) {
        __syncthreads();
        pg8::Gemm g{H, (const bf16*)(ws + WS_WIN), NTOK, DIN, D}; pg8::StaticOrder S; S.init(NTOK, DIN, G, bx);
        pg8::EpiIn E{(bf16*)(ws + WS_U), (bf16*)(ws + WS_GA), (bf16*)(ws + WS_Q), (bf16*)(ws + WS_K), (bf16*)(ws + WS_V), (bf16*)(ws + WS_SBZ), args.in[10], args.in[11], (bf16*)((unsigned char*)args.out + OUT_G8A), (bf16*)((unsigned char*)args.out + OUT_G8B)};
        pg8::gemm_phase<pg8::EpiIn, pg8::StaticOrder, true, true, true>(lds, g, S, E);
    }
    SEAM(2);
    if (IN(3)) { conv_phase(args, tid, G); attn_phase(args, lds, tid, lane, wave, vcu, G); }
    SEAM(3);
    if (IN(4)) {
        __syncthreads();
        pg8::Gemm g{(const bf16*)(ws + WS_GA), (const bf16*)(ws + WS_WPA), NTOK, D, DB, (const bf16*)(ws + WS_Q), (const bf16*)(ws + WS_WPB)}; pg8::PairOrder S; S.init(NTOK, D, G, bx);
        pg8::EpiMerge2 E{(bf16*)(ws + WS_SGA), (const unsigned char*)args.out + OUT_G8A, (const unsigned char*)args.out + OUT_G8B};
        pg8::gemm_phase<pg8::EpiMerge2, pg8::PairOrder, true, true>(lds, g, S, E);
    }
    SEAM(4);
    if (IN(5)) {
        __syncthreads();
        pg8::Gemm g{(const bf16*)(ws + WS_SGA), (const bf16*)(ws + WS_WO), NTOK, D, D}; pg8::StaticOrder S; S.init(NTOK, D, G, bx);
        pg8::EpiOut E{args.in[0], args.in[1], (const float*)(ws + WS_GATE), args.out};
        pg8::gemm_phase<pg8::EpiOut, pg8::StaticOrder, true, true>(lds, g, S, E);
    }
#undef IN
#undef SEAM
}

extern "C" void kernel_launch(void* const* d_in, const int* in_sizes, int n_in, void* d_out, int out_size, void* d_ws, size_t ws_size, hipStream_t stream) {
    static int grid = 0;
    if (grid == 0) {
        if (n_in != 16 || in_sizes[0] != NPROMPT * D || out_size != NTOK * D || ws_size < WS_END) { fprintf(stderr, "kernel_launch: unexpected shapes (n_in %d, in0 %d, out %d, ws %zu)\n", n_in, n_in > 0 ? in_sizes[0] : -1, out_size, ws_size); grid = -1; return; }
        int dev = 0, cus = 0, per_cu = 0;
        hipGetDevice(&dev); hipDeviceGetAttribute(&cus, hipDeviceAttributeMultiprocessorCount, dev);
        if (hipFuncSetAttribute((const void*)hybrid_fwd, hipFuncAttributeMaxDynamicSharedMemorySize, LDS_BYTES) != hipSuccess) { fprintf(stderr, "kernel_launch: hipFuncSetAttribute failed\n"); grid = -1; return; }
        if (hipOccupancyMaxActiveBlocksPerMultiprocessor(&per_cu, (const void*)hybrid_fwd, NWAVES * 64, LDS_BYTES) != hipSuccess || per_cu < 1) { fprintf(stderr, "kernel_launch: occupancy query failed (%d)\n", per_cu); grid = -1; return; }
        grid = cus * per_cu;
        fprintf(stderr, "kernel_launch: %d CUs x %d blocks/CU -> grid %d\n", cus, per_cu, grid);
    }
    if (grid < 0) return;
    Args a{};
    for (int i = 0; i < 16; ++i) a.in[i] = (const float*)d_in[i];
    a.out = (float*)d_out; a.ws = (unsigned char*)d_ws;
#if MK_N_LAUNCHES == 1
    if (hipMemsetAsync((char*)d_ws + WS_BAR, 0, XCD_BAR_WORDS * 4, stream) != hipSuccess) { fprintf(stderr, "kernel_launch: hipMemsetAsync failed\n"); return; }
    a.ph_lo = 0; a.ph_hi = NPHASE;
    void* kargs[] = {&a};
    hipError_t e = hipLaunchCooperativeKernel((const void*)hybrid_fwd, dim3(grid), dim3(NWAVES * 64), kargs, LDS_BYTES, stream);
    if (e != hipSuccess) fprintf(stderr, "kernel_launch: cooperative launch failed: %s (grid %d)\n", hipGetErrorString(e), grid);
#else
    for (int p = 0; p < NPHASE; ++p) { a.ph_lo = p; a.ph_hi = p + 1; hipLaunchKernelGGL(hybrid_fwd, dim3(grid), dim3(NWAVES * 64), LDS_BYTES, stream, a); }
#endif
}
```
